# Optimizing an MI355X kernel written in HIP

```python
import jax, jax.numpy as jnp
from jax import lax
import numpy as np

D_MODEL = 1024
BATCH = 2
SEQ = 16384
DEPTH = 2

NSA_HEADS = 8
NSA_HEAD_DIM = 64
NSA_KV_HEADS = 2
NSA_GROUP = NSA_HEADS // NSA_KV_HEADS
NSA_WIDTH = NSA_HEADS * NSA_HEAD_DIM
KV_WIDTH = NSA_KV_HEADS * NSA_HEAD_DIM
CMP_LEN = 32
CMP_STRIDE = 16
CMP_HIDDEN = 256
SLC_LEN = 64
SLC_TOPN = 16
WINDOW = 512
Q_BLOCK = 128
RET_HEADS = 4
RET_HEAD_DIM = 128
RET_WIDTH = RET_HEADS * RET_HEAD_DIM
RET_CHUNK = 128
MEM_LEN = 256
MEM_HEADS = 4
MEM_HEAD_DIM = D_MODEL // MEM_HEADS
D_FF = 2816
EPS = 1e-6
NEG = -1e30

IN_SIZES = (NSA_WIDTH,
            KV_WIDTH, KV_WIDTH,
            KV_WIDTH, KV_WIDTH,
            KV_WIDTH, KV_WIDTH,
            NSA_HEADS * 3,
            RET_WIDTH, RET_WIDTH, RET_WIDTH, RET_WIDTH)
IN_WIDTH = sum(IN_SIZES)
IN_OFFSETS = tuple(int(o) for o in np.cumsum(IN_SIZES)[:-1])

kernel_name = "hymba_nsa_retention_macaron"


def rms_norm(x, g):
    xf = x.astype(jnp.float32)
    y = xf * lax.rsqrt(jnp.mean(xf * xf, axis=-1, keepdims=True) + EPS)
    return (y * g.astype(jnp.float32)).astype(x.dtype)


def swiglu(x, w_gate, w_up, w_down):
    return (jax.nn.silu(x @ w_gate) * (x @ w_up)) @ w_down


def masked_softmax(s, mask):
    s = jnp.where(mask, s, NEG)
    m = jnp.max(s, axis=-1, keepdims=True)
    p = jnp.where(mask, jnp.exp(s - m), 0.0)
    return p / jnp.maximum(jnp.sum(p, axis=-1, keepdims=True), 1e-30)


def alibi_slopes(n):
    return jnp.asarray(2.0 ** (-8.0 * np.arange(1, n + 1) / n), dtype=jnp.float32)


def compress(kv, pe, w1, w2):
    B, T, G, dh = kv.shape
    nc = (T - CMP_LEN) // CMP_STRIDE + 1
    idx = np.arange(nc)[:, None] * CMP_STRIDE + np.arange(CMP_LEN)[None, :]
    blocks = kv[:, idx] + pe[None, None, :, None, :]
    flat = blocks.transpose(0, 1, 3, 2, 4).reshape(B, nc, G, CMP_LEN * dh)
    return jax.nn.silu(flat @ w1) @ w2


def nsa_mixer(q, k_cmp, v_cmp, k_slc, v_slc, k_win, v_win, gates, cmp_pe, cmp_w1, cmp_w2):
    B, T = q.shape[:2]
    G, R, dh = NSA_KV_HEADS, NSA_GROUP, NSA_HEAD_DIM
    scale = dh ** -0.5
    slopes = alibi_slopes(NSA_HEADS).reshape(G, R)

    kc = compress(k_cmp, cmp_pe[0], cmp_w1[0], cmp_w2[0])
    vc = compress(v_cmp, cmp_pe[1], cmp_w1[1], cmp_w2[1])
    nc = kc.shape[1]
    nsel = T // SLC_LEN
    n_top = min(SLC_TOPN, nsel)

    c_start_np = np.arange(nc) * CMP_STRIDE
    c_end_np = c_start_np + CMP_LEN - 1
    s_start_np = np.arange(nsel) * SLC_LEN
    s_end_np = s_start_np + SLC_LEN - 1
    overlap = jnp.asarray(np.clip(np.minimum(c_end_np[:, None], s_end_np[None, :])
                                  - np.maximum(c_start_np[:, None], s_start_np[None, :]) + 1,
                                  0, None) / CMP_LEN, dtype=jnp.float32)
    c_end = jnp.asarray(c_end_np, dtype=jnp.int32)
    c_mid = jnp.asarray(c_start_np + (CMP_LEN - 1) / 2.0, dtype=jnp.float32)

    k_blocks = k_slc.reshape(B, nsel, SLC_LEN, G, dh).transpose(0, 3, 1, 2, 4)
    v_blocks = v_slc.reshape(B, nsel, SLC_LEN, G, dh).transpose(0, 3, 1, 2, 4)
    k_win_p = jnp.pad(k_win, ((0, 0), (WINDOW, 0), (0, 0), (0, 0)))
    v_win_p = jnp.pad(v_win, ((0, 0), (WINDOW, 0), (0, 0), (0, 0)))

    nb = T // Q_BLOCK
    qb = q.reshape(B, nb, Q_BLOCK, G, R, dh).transpose(1, 0, 2, 3, 4, 5)
    gb = gates.reshape(B, nb, Q_BLOCK, G, R, 3).transpose(1, 0, 2, 3, 4, 5)
    b_ix = jnp.arange(B)[:, None, None, None]
    g_ix = jnp.arange(G)[None, None, :, None]
    jb = jnp.arange(nsel)

    def block_fn(args):
        i, qi, gi = args
        t = i * Q_BLOCK + jnp.arange(Q_BLOCK)
        tf = t.astype(jnp.float32)

        s_c = jnp.einsum('bqgrd,bngd->bgrqn', qi, kc).astype(jnp.float32) * scale
        s_c = s_c - slopes[None, :, :, None, None] * (tf[:, None] - c_mid[None, :])
        p_c = masked_softmax(s_c, (c_end[None, :] <= t[:, None])[None, None, None])
        o_c = jnp.einsum('bgrqn,bngd->bqgrd', p_c.astype(vc.dtype), vc)

        imp = jnp.einsum('bgrqn,nj->bqgj', p_c, overlap)
        cur = t // SLC_LEN
        forced = (jb[None, :] == 0) | (jb[None, :] == cur[:, None]) | (jb[None, :] == cur[:, None] - 1)
        valid = jb[None, :] <= cur[:, None]
        imp = jnp.where(forced[None, :, None, :], 1e4,
                        jnp.where(valid[None, :, None, :], imp, -1.0))
        _, idx = lax.top_k(imp, n_top)

        ks = k_blocks[b_ix, g_ix, idx].reshape(B, Q_BLOCK, G, n_top * SLC_LEN, dh)
        vs = v_blocks[b_ix, g_ix, idx].reshape(B, Q_BLOCK, G, n_top * SLC_LEN, dh)
        spos = (idx[..., None] * SLC_LEN + jnp.arange(SLC_LEN)).reshape(B, Q_BLOCK, G, 1, n_top * SLC_LEN)
        dist_s = t[None, :, None, None, None] - spos
        s_s = jnp.einsum('bqgrd,bqgmd->bqgrm', qi, ks).astype(jnp.float32) * scale
        s_s = s_s - slopes[None, None, :, :, None] * dist_s.astype(jnp.float32)
        p_s = masked_softmax(s_s, dist_s >= 0)
        o_s = jnp.einsum('bqgrm,bqgmd->bqgrd', p_s.astype(vs.dtype), vs)

        kw = lax.dynamic_slice_in_dim(k_win_p, i * Q_BLOCK, WINDOW + Q_BLOCK, axis=1)
        vw = lax.dynamic_slice_in_dim(v_win_p, i * Q_BLOCK, WINDOW + Q_BLOCK, axis=1)
        kpos = i * Q_BLOCK - WINDOW + jnp.arange(WINDOW + Q_BLOCK)
        dist_w = t[:, None] - kpos[None, :]
        mask_w = (dist_w >= 0) & (dist_w < WINDOW) & (kpos[None, :] >= 0)
        s_w = jnp.einsum('bqgrd,bkgd->bqgrk', qi, kw).astype(jnp.float32) * scale
        s_w = s_w - slopes[None, None, :, :, None] * dist_w[None, :, None, None, :].astype(jnp.float32)
        p_w = masked_softmax(s_w, mask_w[None, :, None, None, :])
        o_w = jnp.einsum('bqgrk,bkgd->bqgrd', p_w.astype(vw.dtype), vw)

        gs = jax.nn.sigmoid(gi.astype(jnp.float32))
        o = (gs[..., 0:1] * o_c.astype(jnp.float32) + gs[..., 1:2] * o_s.astype(jnp.float32)
             + gs[..., 2:3] * o_w.astype(jnp.float32))
        return o.reshape(B, Q_BLOCK, NSA_WIDTH).astype(q.dtype)

    out = lax.map(block_fn, (jnp.arange(nb), qb, gb))
    return out.transpose(1, 0, 2, 3).reshape(B, T, NSA_WIDTH)


def retention(q, k, v, g, gn_gain):
    B, T, Hr, d = q.shape
    C = RET_CHUNK
    nch = T // C
    log_g = jnp.log(1.0 - jnp.exp2(-5.0 - jnp.arange(Hr, dtype=jnp.float32)))
    pos = jnp.arange(C, dtype=jnp.float32)
    diff = pos[:, None] - pos[None, :]
    decay_mask = jnp.where(diff >= 0, jnp.exp(jnp.maximum(diff, 0.0) * log_g[:, None, None]), 0.0)
    q_dec = jnp.exp((pos + 1.0) * log_g[:, None])
    k_dec = jnp.exp((C - 1.0 - pos) * log_g[:, None])
    chunk_dec = jnp.exp(C * log_g)

    def to_chunks(a):
        return a.astype(jnp.float32).reshape(B, nch, C, Hr, d).transpose(1, 0, 3, 2, 4)
    qc, kc, vc = to_chunks(q), to_chunks(k * (d ** -0.5)), to_chunks(v)

    def step(state, xs):
        qi, ki, vi = xs
        s = jnp.einsum('bhnd,bhmd->bhnm', qi, ki) * decay_mask[None]
        inner = jnp.einsum('bhnm,bhmd->bhnd', s, vi)
        cross = jnp.einsum('bhnd,bhde->bhne', qi, state) * q_dec[None, :, :, None]
        new_state = (state * chunk_dec[None, :, None, None]
                     + jnp.einsum('bhmd,bhme->bhde', ki * k_dec[None, :, :, None], vi))
        return new_state, inner + cross

    state0 = jnp.zeros((B, Hr, d, d), jnp.float32)
    _, o = lax.scan(step, state0, (qc, kc, vc))
    o = o.transpose(1, 0, 3, 2, 4).reshape(B, T, Hr, d)
    mu = jnp.mean(o, axis=-1, keepdims=True)
    var = jnp.mean(jnp.square(o - mu), axis=-1, keepdims=True)
    o = (o - mu) * lax.rsqrt(var + EPS) * gn_gain.astype(jnp.float32).reshape(Hr, d)
    o = o.reshape(B, T, RET_WIDTH) * jax.nn.silu(g.astype(jnp.float32))
    return o.astype(q.dtype)


def hybrid_mixer(h, w_in, cmp_pe, cmp_w1, cmp_w2, nsa_out_g, ret_gn_g, w_out):
    B, T, _ = h.shape
    parts = jnp.split(h @ w_in, IN_OFFSETS, axis=-1)
    q_n, kc, vc, ks, vs, kw, vw, gates, q_r, k_r, v_r, g_r = parts
    kvs = lambda a: a.reshape(B, T, NSA_KV_HEADS, NSA_HEAD_DIM)
    o_nsa = nsa_mixer(q_n.reshape(B, T, NSA_HEADS, NSA_HEAD_DIM), kvs(kc), kvs(vc), kvs(ks), kvs(vs),
                      kvs(kw), kvs(vw), gates.reshape(B, T, NSA_HEADS, 3), cmp_pe, cmp_w1, cmp_w2)
    o_nsa = rms_norm(o_nsa, nsa_out_g)
    rs = lambda a: a.reshape(B, T, RET_HEADS, RET_HEAD_DIM)
    o_ret = retention(rs(q_r), rs(k_r), rs(v_r), g_r, ret_gn_g)
    return jnp.concatenate([o_nsa, o_ret], axis=-1) @ w_out


def memory_xattn(h, m, wq, wk, wv, wo):
    B, T, _ = h.shape
    M = m.shape[1]
    q = (h @ wq).reshape(B, T, MEM_HEADS, MEM_HEAD_DIM)
    k = (m @ wk).reshape(B, M, MEM_HEADS, MEM_HEAD_DIM)
    v = (m @ wv).reshape(B, M, MEM_HEADS, MEM_HEAD_DIM)
    s = jnp.einsum('bthd,bmhd->bhtm', q, k).astype(jnp.float32) * (MEM_HEAD_DIM ** -0.5)
    p = jax.nn.softmax(s, axis=-1)
    o = jnp.einsum('bhtm,bmhd->bthd', p.astype(v.dtype), v).reshape(B, T, D_MODEL)
    return o @ wo


def setup_inputs(seed: int = 0) -> dict:
    key = jax.random.key(seed)
    ks = jax.random.split(key, 28)
    f32 = jnp.float32

    def dense(k, shape, fan_in):
        return jax.random.normal(k, shape, f32) * (fan_in ** -0.5)

    def gain(k, n):
        return 1.0 + 0.02 * jax.random.normal(k, (DEPTH, n), f32)

    L, dh = CMP_LEN, NSA_HEAD_DIM
    return {
        "x": jax.random.normal(ks[0], (BATCH, SEQ, D_MODEL), f32),
        "mem": jax.random.normal(ks[1], (BATCH, MEM_LEN, D_MODEL), f32),
        "ffn1_pre_g": gain(ks[2], D_MODEL),
        "ffn1_w_gate": dense(ks[3], (DEPTH, D_MODEL, D_FF), D_MODEL),
        "ffn1_w_up": dense(ks[4], (DEPTH, D_MODEL, D_FF), D_MODEL),
        "ffn1_w_down": dense(ks[5], (DEPTH, D_FF, D_MODEL), D_FF),
        "ffn1_post_g": gain(ks[6], D_MODEL),
        "mix_pre_g": gain(ks[7], D_MODEL),
        "w_in": dense(ks[8], (DEPTH, D_MODEL, IN_WIDTH), D_MODEL),
        "cmp_pe": 0.5 * jax.random.normal(ks[9], (DEPTH, 2, L, dh), f32),
        "cmp_w1": dense(ks[10], (DEPTH, 2, L * dh, CMP_HIDDEN), L * dh),
        "cmp_w2": dense(ks[11], (DEPTH, 2, CMP_HIDDEN, dh), CMP_HIDDEN),
        "nsa_out_g": gain(ks[12], NSA_WIDTH),
        "ret_gn_g": gain(ks[13], RET_WIDTH),
        "w_out": dense(ks[14], (DEPTH, NSA_WIDTH + RET_WIDTH, D_MODEL), NSA_WIDTH + RET_WIDTH),
        "mix_post_g": gain(ks[15], D_MODEL),
        "xa_pre_g": gain(ks[16], D_MODEL),
        "xa_mem_g": gain(ks[17], D_MODEL),
        "xa_wq": dense(ks[18], (DEPTH, D_MODEL, D_MODEL), D_MODEL),
        "xa_wk": dense(ks[19], (DEPTH, D_MODEL, D_MODEL), D_MODEL),
        "xa_wv": dense(ks[20], (DEPTH, D_MODEL, D_MODEL), D_MODEL),
        "xa_wo": dense(ks[21], (DEPTH, D_MODEL, D_MODEL), D_MODEL),
        "xa_post_g": gain(ks[22], D_MODEL),
        "ffn2_pre_g": gain(ks[23], D_MODEL),
        "ffn2_w_gate": dense(ks[24], (DEPTH, D_MODEL, D_FF), D_MODEL),
        "ffn2_w_up": dense(ks[25], (DEPTH, D_MODEL, D_FF), D_MODEL),
        "ffn2_w_down": dense(ks[26], (DEPTH, D_FF, D_MODEL), D_FF),
        "ffn2_post_g": gain(ks[27], D_MODEL),
    }


def reference(x, mem, ffn1_pre_g, ffn1_w_gate, ffn1_w_up, ffn1_w_down, ffn1_post_g,
              mix_pre_g, w_in, cmp_pe, cmp_w1, cmp_w2, nsa_out_g, ret_gn_g, w_out, mix_post_g,
              xa_pre_g, xa_mem_g, xa_wq, xa_wk, xa_wv, xa_wo, xa_post_g,
              ffn2_pre_g, ffn2_w_gate, ffn2_w_up, ffn2_w_down, ffn2_post_g):
    for l in range(DEPTH):
        y = swiglu(rms_norm(x, ffn1_pre_g[l]), ffn1_w_gate[l], ffn1_w_up[l], ffn1_w_down[l])
        x = x + 0.5 * rms_norm(y, ffn1_post_g[l])
        y = hybrid_mixer(rms_norm(x, mix_pre_g[l]), w_in[l], cmp_pe[l], cmp_w1[l], cmp_w2[l],
                         nsa_out_g[l], ret_gn_g[l], w_out[l])
        x = x + rms_norm(y, mix_post_g[l])
        y = memory_xattn(rms_norm(x, xa_pre_g[l]), rms_norm(mem, xa_mem_g[l]),
                         xa_wq[l], xa_wk[l], xa_wv[l], xa_wo[l])
        x = x + rms_norm(y, xa_post_g[l])
        y = swiglu(rms_norm(x, ffn2_pre_g[l]), ffn2_w_gate[l], ffn2_w_up[l], ffn2_w_down[l])
        x = x + 0.5 * rms_norm(y, ffn2_post_g[l])
    return x
```

```cpp
#include <hip/hip_runtime.h>
#include <hip/hip_cooperative_groups.h>
#include <stdint.h>
#include <stdio.h>
namespace cg = cooperative_groups;

typedef unsigned short u16;
typedef unsigned int u32;
typedef unsigned long long u64;
using bf16x8 = __attribute__((ext_vector_type(8))) short;
using f32x4 = __attribute__((ext_vector_type(4))) float;
using u32x4 = __attribute__((ext_vector_type(4))) unsigned int;
using u32x2 = __attribute__((ext_vector_type(2))) unsigned int;

constexpr int T = 16384, NTOK = 32768, DM = 1024, DFF = 2816;
constexpr int NPH = 33;
constexpr float EPS = 1e-6f;
constexpr float NEG = -1e30f;

constexpr size_t MiB = 1024ull * 1024ull;
constexpr size_t W_GU1 = 0;
constexpr size_t W_D1 = W_GU1 + 5632ull * 1024 * 2;
constexpr size_t W_IN = W_D1 + 1024ull * 2816 * 2;
constexpr size_t W_C1 = W_IN + 3584ull * 1024 * 2;
constexpr size_t W_C2 = W_C1 + 2ull * 256 * 2048 * 2;
constexpr size_t W_OUT = W_C2 + 2ull * 128 * 256 * 2;
constexpr size_t W_Q = W_OUT + 1024ull * 1024 * 2;
constexpr size_t W_K = W_Q + 1024ull * 1024 * 2;
constexpr size_t W_V = W_K + 1024ull * 1024 * 2;
constexpr size_t W_O = W_V + 1024ull * 1024 * 2;
constexpr size_t W_GU2 = W_O + 1024ull * 1024 * 2;
constexpr size_t W_D2 = W_GU2 + 5632ull * 1024 * 2;
constexpr size_t W_BIAS = W_D2 + 1024ull * 2816 * 2;
constexpr size_t W_END = W_BIAS + 4096;
static_assert(W_END <= 56 * MiB, "W region");
constexpr size_t O_HB = 56 * MiB;
constexpr size_t O_Y = O_HB + 64 * MiB;
constexpr size_t O_BIG = O_Y + 128 * MiB;
constexpr size_t SLACK = 4096;
constexpr size_t B_QN = 0;
constexpr size_t B_KCR = B_QN + 32 * MiB;
constexpr size_t B_VCR = B_KCR + 8 * MiB + SLACK;
constexpr size_t B_KS = B_VCR + 8 * MiB + SLACK;
constexpr size_t B_KW = B_KS + 8 * MiB + SLACK;
constexpr size_t B_VST = B_KW + 8 * MiB + SLACK;
constexpr size_t B_VWT = B_VST + 8 * MiB;
constexpr size_t B_GS = B_VWT + 8 * MiB;
constexpr size_t B_QR = B_GS + 3 * MiB;
constexpr size_t B_KR = B_QR + 32 * MiB;
constexpr size_t B_GR = B_KR + 32 * MiB;
constexpr size_t B_KRT = B_GR + 32 * MiB;
constexpr size_t B_VRT = B_KRT + 32 * MiB;
constexpr size_t B_END = B_VRT + 32 * MiB;
static_assert(B_END <= 244 * MiB, "BIG region");
constexpr size_t O_SMALL = O_BIG + 244 * MiB;
constexpr size_t S_HC = 0;
constexpr size_t S_KCC = S_HC + 4 * MiB;
constexpr size_t S_VCT = S_KCC + 512 * 1024;
constexpr size_t S_MEMN = S_VCT + 512 * 1024;
constexpr size_t S_KMEM = S_MEMN + 2 * MiB;
constexpr size_t S_VMEMT = S_KMEM + 1 * MiB;
constexpr size_t S_END = S_VMEMT + 1 * MiB;
constexpr size_t WS_NEED = O_SMALL + S_END;
static_assert(WS_NEED <= 512 * MiB, "workspace");

constexpr int KEYSTR = 260;
constexpr int SMEM_BYTES = 8 * 16 * KEYSTR * 4;
constexpr int LDSS = 72;

struct P {
  const float *x, *mem, *ffn1_pre_g, *ffn1_wg, *ffn1_wu, *ffn1_wd, *ffn1_post_g, *mix_pre_g, *w_in, *cmp_pe,
      *cmp_w1, *cmp_w2, *nsa_out_g, *ret_gn_g, *w_out, *mix_post_g, *xa_pre_g, *xa_mem_g, *xa_wq, *xa_wk, *xa_wv,
      *xa_wo, *xa_post_g, *ffn2_pre_g, *ffn2_wg, *ffn2_wu, *ffn2_wd, *ffn2_post_g;
  float* out;
  unsigned char* ws;
};

__device__ __forceinline__ u16 f2bf(float f) {
  u32 u = __float_as_uint(f);
  u += 0x7FFFu + ((u >> 16) & 1u);
  return (u16)(u >> 16);
}
__device__ __forceinline__ float bf2f(u16 h) { return __uint_as_float(((u32)h) << 16); }
__device__ __forceinline__ u32 pack2(float a, float b) { return (u32)f2bf(a) | ((u32)f2bf(b) << 16); }
__device__ __forceinline__ float silu_f(float v) { return v / (1.f + __expf(-v)); }
__device__ __forceinline__ float sigm_f(float v) { return 1.f / (1.f + __expf(-v)); }
__device__ __forceinline__ float shx(float v, int m) { return __shfl_xor(v, m, 64); }
__device__ __forceinline__ float wave_sum(float v) {
#pragma unroll
  for (int o = 32; o >= 1; o >>= 1) v += __shfl_xor(v, o, 64);
  return v;
}
__device__ __forceinline__ f32x4 mfma16(bf16x8 a, bf16x8 b, f32x4 c) {
  return __builtin_amdgcn_mfma_f32_16x16x32_bf16(a, b, c, 0, 0, 0);
}
__device__ __forceinline__ bf16x8 ld8(const u16* p) { return *reinterpret_cast<const bf16x8*>(p); }
__device__ __forceinline__ bf16x8 ld4x2(const u16* p0, const u16* p1) {
  u32x2 a = *reinterpret_cast<const u32x2*>(p0);
  u32x2 b = *reinterpret_cast<const u32x2*>(p1);
  u32x4 r = {a.x, a.y, b.x, b.y};
  return __builtin_bit_cast(bf16x8, r);
}
__device__ __forceinline__ bf16x8 packp(f32x4 a, f32x4 b) {
  u32x4 r = {pack2(a[0], a[1]), pack2(a[2], a[3]), pack2(b[0], b[1]), pack2(b[2], b[3])};
  return __builtin_bit_cast(bf16x8, r);
}
__device__ __forceinline__ void st4bf(u16* p, f32x4 v) {
  u32x2 r = {pack2(v[0], v[1]), pack2(v[2], v[3])};
  *reinterpret_cast<u32x2*>(p) = r;
}
__device__ __forceinline__ float ret_lg(int h) { return log2f(1.f - exp2f(-5.f - (float)h)); }

__device__ __forceinline__ int tidx() {
  int t = threadIdx.x;
  asm volatile("" : "+v"(t));
  return t;
}
__device__ __forceinline__ int bidx() {
  int t = blockIdx.x;
  asm volatile("" : "+s"(t));
  return t;
}
__device__ __forceinline__ int gdim() {
  int t = gridDim.x;
  asm volatile("" : "+s"(t));
  return t;
}
__device__ __forceinline__ int wmap(int mode, int n) {
  if (mode == 1) return (n >> 4) * 32 + (n & 15);
  if (mode == 2) return (n >> 4) * 32 + 16 + (n & 15);
  if (mode == 3) return n < 1280 ? n : (n < 1304 ? 3328 + (n - 1280) : n - 24);
  return n;
}
__device__ __forceinline__ void tconv(const float* __restrict__ src, int K, int N, u16* __restrict__ dst, int mode, int& tbase,
                      float* tile) {
  const int nkt = K >> 6, nnt = (N + 63) >> 6, ntl = nkt * nnt;
  const int G = gdim();
  int tl0 = (bidx() - (tbase % G) + G) % G;
  const int tid = tidx();
  for (int tl = tl0; tl < ntl; tl += G) {
    const int k0 = (tl / nnt) << 6, n0 = (tl % nnt) << 6;
#pragma unroll
    for (int i = 0; i < 8; ++i) {
      int kk = (tid >> 6) + i * 8, nn = tid & 63;
      float v = 0.f;
      if (n0 + nn < N) v = src[(size_t)(k0 + kk) * N + n0 + nn];
      tile[kk * 65 + nn] = v;
    }
    __syncthreads();
    {
      int nn = tid >> 3, ch = tid & 7;
      if (n0 + nn < N) {
        u32x4 r;
        r.x = pack2(tile[(ch * 8 + 0) * 65 + nn], tile[(ch * 8 + 1) * 65 + nn]);
        r.y = pack2(tile[(ch * 8 + 2) * 65 + nn], tile[(ch * 8 + 3) * 65 + nn]);
        r.z = pack2(tile[(ch * 8 + 4) * 65 + nn], tile[(ch * 8 + 5) * 65 + nn]);
        r.w = pack2(tile[(ch * 8 + 6) * 65 + nn], tile[(ch * 8 + 7) * 65 + nn]);
        *reinterpret_cast<u32x4*>(dst + (size_t)wmap(mode, n0 + nn) * K + k0 + ch * 8) = r;
      }
    }
    __syncthreads();
  }
  tbase += ntl;
}

__device__ __forceinline__ void convert_layer(const P& p, int l, unsigned char* smem) {
  float* tile = reinterpret_cast<float*>(smem);
  unsigned char* W = p.ws;
  int tb = 0;
  tconv(p.ffn1_wg + (size_t)l * DM * DFF, DM, DFF, (u16*)(W + W_GU1), 1, tb, tile);
  tconv(p.ffn1_wu + (size_t)l * DM * DFF, DM, DFF, (u16*)(W + W_GU1), 2, tb, tile);
  tconv(p.ffn1_wd + (size_t)l * DFF * DM, DFF, DM, (u16*)(W + W_D1), 0, tb, tile);
  tconv(p.w_in + (size_t)l * DM * 3352, DM, 3352, (u16*)(W + W_IN), 3, tb, tile);
  tconv(p.cmp_w1 + (size_t)(l * 2 + 0) * 2048 * 256, 2048, 256, (u16*)(W + W_C1), 0, tb, tile);
  tconv(p.cmp_w1 + (size_t)(l * 2 + 1) * 2048 * 256, 2048, 256, (u16*)(W + W_C1) + 256 * 2048, 0, tb, tile);
  tconv(p.cmp_w2 + (size_t)(l * 2 + 0) * 256 * 64, 256, 64, (u16*)(W + W_C2), 0, tb, tile);
  tconv(p.cmp_w2 + (size_t)(l * 2 + 1) * 256 * 64, 256, 64, (u16*)(W + W_C2) + 128 * 256, 0, tb, tile);
  tconv(p.w_out + (size_t)l * DM * DM, DM, DM, (u16*)(W + W_OUT), 0, tb, tile);
  tconv(p.xa_wq + (size_t)l * DM * DM, DM, DM, (u16*)(W + W_Q), 0, tb, tile);
  tconv(p.xa_wk + (size_t)l * DM * DM, DM, DM, (u16*)(W + W_K), 0, tb, tile);
  tconv(p.xa_wv + (size_t)l * DM * DM, DM, DM, (u16*)(W + W_V), 0, tb, tile);
  tconv(p.xa_wo + (size_t)l * DM * DM, DM, DM, (u16*)(W + W_O), 0, tb, tile);
  tconv(p.ffn2_wg + (size_t)l * DM * DFF, DM, DFF, (u16*)(W + W_GU2), 1, tb, tile);
  tconv(p.ffn2_wu + (size_t)l * DM * DFF, DM, DFF, (u16*)(W + W_GU2), 2, tb, tile);
  tconv(p.ffn2_wd + (size_t)l * DFF * DM, DFF, DM, (u16*)(W + W_D2), 0, tb, tile);
  const int gt = bidx() * 512 + tidx(), nt = gdim() * 512;
  {
    u32* z = reinterpret_cast<u32*>((u16*)(W + W_IN) + (size_t)3352 * 1024);
    for (int i = gt; i < 232 * 512; i += nt) z[i] = 0u;
    for (int kv = 0; kv < 2; ++kv) {
      u32* z2 = reinterpret_cast<u32*>((u16*)(W + W_C2) + (size_t)kv * 128 * 256 + 64 * 256);
      for (int i = gt; i < 64 * 128; i += nt) z2[i] = 0u;
    }
  }
  if (gt < 512) {
    int kv = gt >> 8, c = gt & 255;
    const float* pe = p.cmp_pe + (size_t)(l * 2 + kv) * 2048;
    const float* w1 = p.cmp_w1 + (size_t)(l * 2 + kv) * 2048 * 256;
    float s = 0.f;
    for (int k = 0; k < 2048; ++k) s += pe[k] * w1[(size_t)k * 256 + c];
    reinterpret_cast<float*>(W + W_BIAS)[gt] = s;
  }
}

__device__ __forceinline__ void norm_phase(const float* __restrict__ xin, const float* __restrict__ y, const float* __restrict__ gpost,
                           float w, float* __restrict__ xout, const float* __restrict__ gpre, u16* __restrict__ hb,
                           int ntok) {
  const int lane = tidx() & 63;
  const int gw = bidx() * 8 + __builtin_amdgcn_readfirstlane(tidx() >> 6), nw = gdim() * 8;
  for (int tok = gw; tok < ntok; tok += nw) {
    f32x4 xv[4];
#pragma unroll
    for (int i = 0; i < 4; ++i) xv[i] = *reinterpret_cast<const f32x4*>(xin + (size_t)tok * 1024 + i * 256 + lane * 4);
    if (y) {
      f32x4 yv[4];
      float ss = 0.f;
#pragma unroll
      for (int i = 0; i < 4; ++i) {
        yv[i] = *reinterpret_cast<const f32x4*>(y + (size_t)tok * 1024 + i * 256 + lane * 4);
        ss += yv[i][0] * yv[i][0] + yv[i][1] * yv[i][1] + yv[i][2] * yv[i][2] + yv[i][3] * yv[i][3];
      }
      ss = wave_sum(ss);
      float r = rsqrtf(ss * (1.f / 1024.f) + EPS) * w;
#pragma unroll
      for (int i = 0; i < 4; ++i) {
        f32x4 g = *reinterpret_cast<const f32x4*>(gpost + i * 256 + lane * 4);
        xv[i] += yv[i] * g * r;
      }
    }
    if (xout) {
#pragma unroll
      for (int i = 0; i < 4; ++i) *reinterpret_cast<f32x4*>(xout + (size_t)tok * 1024 + i * 256 + lane * 4) = xv[i];
    }
    if (hb) {
      float ss = 0.f;
#pragma unroll
      for (int i = 0; i < 4; ++i) ss += xv[i][0] * xv[i][0] + xv[i][1] * xv[i][1] + xv[i][2] * xv[i][2] + xv[i][3] * xv[i][3];
      ss = wave_sum(ss);
      float r = rsqrtf(ss * (1.f / 1024.f) + EPS);
#pragma unroll
      for (int i = 0; i < 4; ++i) {
        f32x4 g = *reinterpret_cast<const f32x4*>(gpre + i * 256 + lane * 4);
        st4bf(hb + (size_t)tok * 1024 + i * 256 + lane * 4, xv[i] * g * r);
      }
    }
  }
}

enum { EP_SWIGLU = 0, EP_F32 = 1, EP_WIN = 2, EP_C1 = 3, EP_C2K = 4, EP_C2V = 5, EP_BF16 = 6, EP_VMEMT = 7 };

template <int MODE>
__device__ __forceinline__ void epi_store(const P& p, int aux, float scale, void* outp, int ldo, int row, int col,
                                          f32x4 v) {
  unsigned char* ws = p.ws;
  if constexpr (MODE == EP_F32) {
    float* o = (float*)outp;
#pragma unroll
    for (int i = 0; i < 4; ++i) o[(size_t)(row + i) * ldo + col] = v[i];
  } else if constexpr (MODE == EP_BF16) {
    u16* o = (u16*)outp;
#pragma unroll
    for (int i = 0; i < 4; ++i) o[(size_t)(row + i) * ldo + col] = f2bf(v[i] * scale);
  } else if constexpr (MODE == EP_C1) {
    u16* o = (u16*)outp;
    float bia = reinterpret_cast<const float*>(ws + W_BIAS)[aux * 256 + col];
#pragma unroll
    for (int i = 0; i < 4; ++i) o[(size_t)(row + i) * 256 + col] = f2bf(silu_f(v[i] + bia));
  } else if constexpr (MODE == EP_C2K) {
    if (col < 64) {
      u16* o = (u16*)outp;
#pragma unroll
      for (int i = 0; i < 4; ++i) o[(size_t)(row + i) * 64 + col] = f2bf(v[i]);
    }
  } else if constexpr (MODE == EP_C2V) {
    if (col < 64) {
      u16* o = (u16*)outp;
      int bg = row >> 10, n = row & 1023;
      st4bf(o + (size_t)bg * 65536 + (size_t)(n >> 6) * 4096 + col * 64 + (n & 63), v);
    }
  } else if constexpr (MODE == EP_VMEMT) {
    u16* o = (u16*)outp;
    int b = row >> 8, m = row & 255;
    st4bf(o + ((size_t)b * 1024 + col) * 256 + m, v);
  } else if constexpr (MODE == EP_WIN) {
    unsigned char* big = ws + O_BIG;
    const int b = row >> 14, t = row & 16383;
    if (col < 512) {
      u16* o = (u16*)(big + B_QN);
#pragma unroll
      for (int i = 0; i < 4; ++i) o[(size_t)(row + i) * 512 + col] = f2bf(v[i] * 0.125f);
    } else if (col < 1280) {
      const int s = (col - 512) >> 7, cc = (col - 512) & 127, g = cc >> 6, d = cc & 63, bg = b * 2 + g;
      if (s == 3 || s == 5) {
        u16* o = (u16*)(big + (s == 3 ? B_VST : B_VWT));
        st4bf(o + ((size_t)(bg * 256 + (t >> 6)) * 4096 + d * 64 + (t & 63)), v);
      } else {
        u16* o = (u16*)(big + (s == 0 ? B_KCR : (s == 1 ? B_VCR : (s == 2 ? B_KS : B_KW))));
        o += ((size_t)bg * T + t) * 64 + d;
#pragma unroll
        for (int i = 0; i < 4; ++i) o[i * 64] = f2bf(v[i]);
      }
    } else if (col < 3328) {
      const int cr = col - 1280, wh = cr >> 9, cc = cr & 511, h = cc >> 7, d = cc & 127;
      const float s128 = 0.08838834764831845f;
      if (wh == 0) {
        u16* o = (u16*)(big + B_QR);
#pragma unroll
        for (int i = 0; i < 4; ++i) o[(size_t)(row + i) * 512 + cc] = f2bf(v[i]);
      } else if (wh == 1) {
        u16* o = (u16*)(big + B_KR);
#pragma unroll
        for (int i = 0; i < 4; ++i) o[(size_t)(row + i) * 512 + cc] = f2bf(v[i] * s128);
        u16* ot = (u16*)(big + B_KRT);
        const float lg = ret_lg(h);
        const int tm = t & 127;
        f32x4 w;
#pragma unroll
        for (int i = 0; i < 4; ++i) w[i] = v[i] * s128 * exp2f((float)(127 - tm - i) * lg);
        st4bf(ot + ((size_t)((b * 4 + h) * 128 + (t >> 7)) * 16384 + d * 128 + tm), w);
      } else if (wh == 2) {
        u16* ot = (u16*)(big + B_VRT);
        st4bf(ot + ((size_t)((b * 4 + h) * 128 + (t >> 7)) * 16384 + d * 128 + (t & 127)), v);
      } else {
        u16* o = (u16*)(big + B_GR);
#pragma unroll
        for (int i = 0; i < 4; ++i) o[(size_t)(row + i) * 512 + cc] = f2bf(silu_f(v[i]));
      }
    } else if (col < 3352) {
      float* o = (float*)(big + B_GS);
#pragma unroll
      for (int i = 0; i < 4; ++i) o[(size_t)(row + i) * 24 + (col - 3328)] = sigm_f(v[i]);
    }
  }
}

template <int MODE>
__device__ __forceinline__ void gemm_tile(const P& p, int aux, float scale, void* outp, int ldo, const u16* __restrict__ A, size_t lda,
                          const u16* __restrict__ Bt, size_t ldb, int K, int brow, int bcol, u16* sm) {
  const int tid = tidx(), lane = tid & 63, wid = __builtin_amdgcn_readfirstlane(tid >> 6);
  const int wr = wid >> 1, wc = wid & 1, fr = lane & 15, fq = lane >> 4;
  u16* smA = sm;
  u16* smB = sm + 2 * 256 * LDSS;
  f32x4 acc[4][4];
#pragma unroll
  for (int m = 0; m < 4; ++m)
#pragma unroll
    for (int n = 0; n < 4; ++n) acc[m][n] = f32x4{0.f, 0.f, 0.f, 0.f};
  u32x4 ra[4], rb[2];
  const int nt = K >> 6;
  auto gload = [&](int kt) {
#pragma unroll
    for (int i = 0; i < 4; ++i) {
      int c = tid + i * 512;
      ra[i] = *reinterpret_cast<const u32x4*>(A + (size_t)(brow + (c >> 3)) * lda + (size_t)kt * 64 + (c & 7) * 8);
    }
#pragma unroll
    for (int i = 0; i < 2; ++i) {
      int c = tid + i * 512;
      rb[i] = *reinterpret_cast<const u32x4*>(Bt + (size_t)(bcol + (c >> 3)) * ldb + (size_t)kt * 64 + (c & 7) * 8);
    }
  };
  auto swrite = [&](int buf) {
#pragma unroll
    for (int i = 0; i < 4; ++i) {
      int c = tid + i * 512;
      *reinterpret_cast<u32x4*>(smA + buf * 256 * LDSS + (c >> 3) * LDSS + (c & 7) * 8) = ra[i];
    }
#pragma unroll
    for (int i = 0; i < 2; ++i) {
      int c = tid + i * 512;
      *reinterpret_cast<u32x4*>(smB + buf * 128 * LDSS + (c >> 3) * LDSS + (c & 7) * 8) = rb[i];
    }
  };
  gload(0);
  swrite(0);
  __syncthreads();
  for (int kt = 0; kt < nt; ++kt) {
    const int buf = kt & 1;
    if (kt + 1 < nt) gload(kt + 1);
    const u16* a0 = smA + buf * 256 * LDSS + (wr * 64 + fr) * LDSS + fq * 8;
    const u16* b0 = smB + buf * 128 * LDSS + (wc * 64 + fr) * LDSS + fq * 8;
#pragma unroll
    for (int ks = 0; ks < 2; ++ks) {
      bf16x8 af[4], bfr[4];
#pragma unroll
      for (int m = 0; m < 4; ++m) af[m] = ld8(a0 + m * 16 * LDSS + ks * 32);
#pragma unroll
      for (int n = 0; n < 4; ++n) bfr[n] = ld8(b0 + n * 16 * LDSS + ks * 32);
#pragma unroll
      for (int m = 0; m < 4; ++m)
#pragma unroll
        for (int n = 0; n < 4; ++n) acc[m][n] = mfma16(af[m], bfr[n], acc[m][n]);
    }
    if (kt + 1 < nt) swrite(buf ^ 1);
    __syncthreads();
  }
#pragma unroll
  for (int m = 0; m < 4; ++m) {
    const int row = brow + wr * 64 + m * 16 + fq * 4;
    if constexpr (MODE == EP_SWIGLU) {
#pragma unroll
      for (int n = 0; n < 4; n += 2) {
        const int cb = bcol + wc * 64 + n * 16;
        const int oc = (cb >> 5) * 16 + fr;
        u16* o = (u16*)outp;
#pragma unroll
        for (int i = 0; i < 4; ++i)
          o[(size_t)(row + i) * DFF + oc] = f2bf(silu_f(acc[m][n][i]) * acc[m][n + 1][i]);
      }
    } else {
#pragma unroll
      for (int n = 0; n < 4; ++n)
        epi_store<MODE>(p, aux, scale, outp, ldo, row, bcol + wc * 64 + n * 16 + fr, acc[m][n]);
    }
  }
}

template <int MODE>
__device__ __forceinline__ void gemm_phase(const P& p, int aux, float scale, void* outp, int ldo, const u16* A, size_t lda,
                           const u16* Bt, size_t ldb, int M, int N, int K, u16* sm, bool rev) {
  const int nNt = N >> 7, ntl = (M >> 8) * nNt;
  const int bid = rev ? (int)(gdim() - 1 - bidx()) : bidx();
  for (int tl = bid; tl < ntl; tl += gdim())
    gemm_tile<MODE>(p, aux, scale, outp, ldo, A, lda, Bt, ldb, K, (tl / nNt) << 8, (tl % nNt) << 7, sm);
}

__device__ __forceinline__ void ld_kf(const u16* __restrict__ kp, bf16x8 (&Kf)[2][2], int fr, int fq) {
#pragma unroll
  for (int tl = 0; tl < 2; ++tl)
#pragma unroll
    for (int ks = 0; ks < 2; ++ks) Kf[tl][ks] = ld8(kp + (tl * 16 + fr) * 64 + ks * 32 + fq * 8);
}
__device__ __forceinline__ void qk_r(const bf16x8 (&Kf)[2][2], const bf16x8 (&Qr)[2], f32x4& s0, f32x4& s1) {
  f32x4 z = {0.f, 0.f, 0.f, 0.f};
  s0 = mfma16(Kf[0][0], Qr[0], z);
  s0 = mfma16(Kf[0][1], Qr[1], s0);
  s1 = mfma16(Kf[1][0], Qr[0], z);
  s1 = mfma16(Kf[1][1], Qr[1], s1);
}
__device__ __forceinline__ void pv_tiles(const u16* __restrict__ vp, const bf16x8 (&Pb)[4], f32x4 (&O)[4][4], int fr,
                                         int fq) {
#pragma unroll
  for (int dt = 0; dt < 4; ++dt) {
    bf16x8 Vf = ld4x2(vp + (dt * 16 + fr) * 64 + fq * 4, vp + (dt * 16 + fr) * 64 + 16 + fq * 4);
#pragma unroll
    for (int r = 0; r < 4; ++r) O[r][dt] = mfma16(Vf, Pb[r], O[r][dt]);
  }
}

template <int MODE>
__device__ __forceinline__ void att_step(const u16* __restrict__ kp, const u16* __restrict__ vp, int kbase, int t,
                                         bool selq, const bf16x8* qlds, int lane, const float (&slope)[4],
                                         float (&m)[4], float (&ls)[4], f32x4 (&O)[4][4], int fr, int fq) {
  bf16x8 Kf[2][2];
  ld_kf(kp, Kf, fr, fq);
  bf16x8 Pb[4];
  const int d0 = t - (kbase + fq * 4);
#pragma unroll
  for (int r = 0; r < 4; ++r) {
    f32x4 sv[2];
    bf16x8 Qr[2];
    Qr[0] = qlds[(r * 2 + 0) * 64 + lane];
    Qr[1] = qlds[(r * 2 + 1) * 64 + lane];
    qk_r(Kf, Qr, sv[0], sv[1]);
    float mx = NEG;
#pragma unroll
    for (int tl = 0; tl < 2; ++tl)
#pragma unroll
      for (int i = 0; i < 4; ++i) {
        const int dist = d0 - tl * 16 - i;
        bool v;
        if (MODE == 1) v = selq && (dist >= 0);
        else v = (dist >= 0) && (dist < 512);
        float s = sv[tl][i] - slope[r] * (float)dist;
        s = v ? s : NEG;
        sv[tl][i] = s;
        mx = fmaxf(mx, s);
      }
    mx = fmaxf(mx, shx(mx, 16));
    mx = fmaxf(mx, shx(mx, 32));
    const float mn = fmaxf(m[r], mx);
    const float alpha = __expf(m[r] - mn);
    float sum = 0.f;
#pragma unroll
    for (int tl = 0; tl < 2; ++tl)
#pragma unroll
      for (int i = 0; i < 4; ++i) {
        float s = sv[tl][i];
        float pv = (s > -1e29f) ? __expf(s - mn) : 0.f;
        sv[tl][i] = pv;
        sum += pv;
      }
    ls[r] = ls[r] * alpha + sum;
    m[r] = mn;
#pragma unroll
    for (int dt = 0; dt < 4; ++dt) O[r][dt] *= alpha;
    Pb[r] = packp(sv[0], sv[1]);
  }
  pv_tiles(vp, Pb, O, fr, fq);
}

__device__ __forceinline__ void nsa_task(const P& p, int l, int b, int qt, u32* keys) {
  int lane = tidx() & 63, fr = lane & 15, fq = lane >> 4;
#define LAUNDER() asm volatile("" : "+v"(fr), "+v"(fq), "+v"(lane))
  const int t0 = qt * 16, t = t0 + fr, cur = t0 >> 6;
  const size_t tok = (size_t)b * T + t;
  unsigned char* big = p.ws + O_BIG;
  const u16* QN = (const u16*)(big + B_QN);
  const float* GS = (const float*)(big + B_GS);
  float* ONSA = (float*)(p.ws + O_Y);
  u16* CAT = (u16*)(p.ws + O_HB);
  u32* krow = keys + fr * KEYSTR;
  float ssq = 0.f;
  f32x4 O[4][4];
#pragma unroll 1
  for (int g = 0; g < 2; ++g) {
    const int bg = b * 2 + g;
    bf16x8 Qf[4][2];
    float slope[4];
#pragma unroll
    for (int r = 0; r < 4; ++r) {
#pragma unroll
      for (int ks = 0; ks < 2; ++ks) Qf[r][ks] = ld8(QN + tok * 512 + (g * 4 + r) * 64 + ks * 32 + fq * 8);
      slope[r] = exp2f(-(float)(g * 4 + r + 1));
    }
    const float* gsp = GS + tok * 24 + g * 12;
    float* onp = ONSA + tok * 512 + g * 256 + fq * 4;
    const u16* Kc = (const u16*)(p.ws + O_SMALL + S_KCC) + (size_t)bg * 65536;
    const u16* Vc = (const u16*)(p.ws + O_SMALL + S_VCT) + (size_t)bg * 65536;
    float m[4], ls[4];
    LAUNDER();
    const int nlast = (t0 + 15 - 31) >> 4;
    const int nit = nlast >= 0 ? (nlast >> 5) + 1 : 0;
#pragma unroll
    for (int r = 0; r < 4; ++r) { m[r] = NEG; ls[r] = 0.f; }
#pragma unroll 1
    for (int it = 0; it < nit; ++it) {
      bf16x8 Kf[2][2];
      ld_kf(Kc + (size_t)it * 32 * 64, Kf, fr, fq);
#pragma unroll
      for (int r = 0; r < 4; ++r) {
        f32x4 sv[2];
        qk_r(Kf, Qf[r], sv[0], sv[1]);
        float mx = NEG;
#pragma unroll
        for (int tl = 0; tl < 2; ++tl)
#pragma unroll
          for (int i = 0; i < 4; ++i) {
            const int n = it * 32 + tl * 16 + fq * 4 + i;
            const bool v = (16 * n + 31 <= t);
            float s = sv[tl][i] - slope[r] * ((float)t - (16.f * (float)n + 15.5f));
            s = v ? s : NEG;
            sv[tl][i] = s;
            mx = fmaxf(mx, s);
          }
        mx = fmaxf(mx, shx(mx, 16));
        mx = fmaxf(mx, shx(mx, 32));
        const float mn = fmaxf(m[r], mx);
        const float alpha = __expf(m[r] - mn);
        float sum = 0.f;
#pragma unroll
        for (int tl = 0; tl < 2; ++tl)
#pragma unroll
          for (int i = 0; i < 4; ++i) {
            float s = sv[tl][i];
            sum += (s > -1e29f) ? __expf(s - mn) : 0.f;
          }
        ls[r] = ls[r] * alpha + sum;
        m[r] = mn;
      }
    }
    float linv[4];
#pragma unroll
    for (int r = 0; r < 4; ++r) {
      float lt = ls[r] + shx(ls[r], 16);
      lt += shx(lt, 32);
      linv[r] = 1.f / fmaxf(lt, 1e-30f);
    }
    LAUNDER();
#pragma unroll 1
    for (int i = 0; i < 16; ++i) {
      const u32 j = fq * 64 + i * 4;
      u32x4 kv = {255u - j, 254u - j, 253u - j, 252u - j};
      *reinterpret_cast<u32x4*>(krow + j) = kv;
    }
#pragma unroll
    for (int r = 0; r < 4; ++r)
#pragma unroll
      for (int dt = 0; dt < 4; ++dt) O[r][dt] = f32x4{0.f, 0.f, 0.f, 0.f};
    LAUNDER();
    float carry = 0.f;
#pragma unroll 1
    for (int it = 0; it < nit; ++it) {
      bf16x8 Kf[2][2];
      ld_kf(Kc + (size_t)it * 32 * 64, Kf, fr, fq);
      bf16x8 Pb[4];
      f32x4 ps[2] = {f32x4{0.f, 0.f, 0.f, 0.f}, f32x4{0.f, 0.f, 0.f, 0.f}};
#pragma unroll
      for (int r = 0; r < 4; ++r) {
        f32x4 sv[2];
        qk_r(Kf, Qf[r], sv[0], sv[1]);
#pragma unroll
        for (int tl = 0; tl < 2; ++tl) {
#pragma unroll
          for (int i = 0; i < 4; ++i) {
            const int n = it * 32 + tl * 16 + fq * 4 + i;
            const bool v = (16 * n + 31 <= t);
            float s = sv[tl][i] - slope[r] * ((float)t - (16.f * (float)n + 15.5f));
            sv[tl][i] = v ? __expf(s - m[r]) * linv[r] : 0.f;
          }
          ps[tl] += sv[tl];
        }
        Pb[r] = packp(sv[0], sv[1]);
      }
#pragma unroll
      for (int tl = 0; tl < 2; ++tl) {
        const float a = ps[tl][0] + ps[tl][1] + ps[tl][2] + 0.5f * ps[tl][3];
        const float c = 0.5f * ps[tl][3];
        const float rcv = __shfl(c, (lane + 48) & 63, 64);
        const float add = fq > 0 ? rcv : carry;
        carry = rcv;
        const int j = it * 8 + tl * 4 + fq;
        krow[j] = (__float_as_uint(a + add) & 0xFFFFFF00u) | (u32)(255 - j);
      }
      pv_tiles(Vc + (size_t)(it >> 1) * 4096 + (it & 1) * 32, Pb, O, fr, fq);
    }
    LAUNDER();
    {
#pragma unroll
      for (int r = 0; r < 4; ++r) {
        const float gt = gsp[r * 3 + 0];
#pragma unroll
        for (int dt = 0; dt < 4; ++dt) *reinterpret_cast<f32x4*>(onp + r * 64 + dt * 16) = O[r][dt] * gt;
      }
    }
    LAUNDER();
    {
      const u32 F = 0x461C4000u;
      if (fq == 0) krow[0] = F | 255u;
      if (fq == (cur >> 6)) krow[cur] = F | (u32)(255 - cur);
      if (cur >= 1 && fq == ((cur - 1) >> 6)) krow[cur - 1] = F | (u32)(255 - (cur - 1));
    }
    __builtin_amdgcn_wave_barrier();
    u64 mymask = 0ull;
#pragma unroll 1
    for (int rd = 0; rd < 16; ++rd) {
      u32 mx = 0u;
      const u32x4* k4 = reinterpret_cast<const u32x4*>(krow + fq * 64);
#pragma unroll
      for (int i = 0; i < 16; ++i) {
        u32x4 v = k4[i];
        u32 a = v.x > v.y ? v.x : v.y;
        u32 c = v.z > v.w ? v.z : v.w;
        a = a > c ? a : c;
        mx = mx > a ? mx : a;
      }
      u32 o1 = (u32)__shfl_xor((int)mx, 16, 64);
      mx = mx > o1 ? mx : o1;
      u32 o2 = (u32)__shfl_xor((int)mx, 32, 64);
      mx = mx > o2 ? mx : o2;
      const int jw = 255 - (int)(mx & 255u);
      if ((jw >> 6) == fq) {
        krow[jw] = 0u;
        mymask |= 1ull << (jw & 63);
      }
      __builtin_amdgcn_wave_barrier();
    }
    u32 ulo = (u32)mymask, uhi = (u32)(mymask >> 32);
#pragma unroll
    for (int o = 1; o <= 8; o <<= 1) {
      ulo |= (u32)__shfl_xor((int)ulo, o, 64);
      uhi |= (u32)__shfl_xor((int)uhi, o, 64);
    }
    bf16x8* qlds = reinterpret_cast<bf16x8*>(keys);
    __builtin_amdgcn_wave_barrier();
#pragma unroll
    for (int r = 0; r < 4; ++r)
#pragma unroll
      for (int ks = 0; ks < 2; ++ks) qlds[(r * 2 + ks) * 64 + lane] = Qf[r][ks];
    LAUNDER();
    const u16* KS = (const u16*)(big + B_KS) + (size_t)bg * T * 64;
    const u16* VST = (const u16*)(big + B_VST) + (size_t)bg * 256 * 4096;
#pragma unroll
    for (int r = 0; r < 4; ++r) {
      m[r] = NEG; ls[r] = 0.f;
#pragma unroll
      for (int dt = 0; dt < 4; ++dt) O[r][dt] = f32x4{0.f, 0.f, 0.f, 0.f};
    }
#pragma unroll 1
    for (int part = 0; part < 4; ++part) {
      u64 um = ((u64)(u32)__builtin_amdgcn_readlane((int)uhi, part * 16) << 32) |
               (u64)(u32)__builtin_amdgcn_readlane((int)ulo, part * 16);
      while (um) {
        const int bit = __builtin_ctzll(um);
        um &= um - 1;
        const int j = part * 64 + bit;
        if (j > cur) break;
        const int sb = (int)((mymask >> bit) & 1ull);
        const bool selq = __shfl(sb, fr + 16 * part, 64) != 0;
        const int nh = (j == cur) ? (((t0 + 15 - 64 * cur) >> 5) + 1) : 2;
#pragma unroll 1
        for (int h = 0; h < nh; ++h)
          att_step<1>(KS + (size_t)(64 * j + 32 * h) * 64, VST + (size_t)j * 4096 + 32 * h, 64 * j + 32 * h, t, selq, qlds,
                      lane, slope, m, ls, O, fr, fq);
      }
    }
    LAUNDER();
#pragma unroll
    for (int r = 0; r < 4; ++r) {
      float lt = ls[r] + shx(ls[r], 16);
      lt += shx(lt, 32);
      const float sc = gsp[r * 3 + 1] / fmaxf(lt, 1e-30f);
#pragma unroll
      for (int dt = 0; dt < 4; ++dt) {
        f32x4* ptr = reinterpret_cast<f32x4*>(onp + r * 64 + dt * 16);
        *ptr = *ptr + O[r][dt] * sc;
      }
    }
    LAUNDER();
    const u16* KW = (const u16*)(big + B_KW) + (size_t)bg * T * 64;
    const u16* VWT = (const u16*)(big + B_VWT) + (size_t)bg * 256 * 4096;
#pragma unroll
    for (int r = 0; r < 4; ++r) {
      m[r] = NEG; ls[r] = 0.f;
#pragma unroll
      for (int dt = 0; dt < 4; ++dt) O[r][dt] = f32x4{0.f, 0.f, 0.f, 0.f};
    }
    {
      const int lo = t0 - 511 > 0 ? t0 - 511 : 0;
#pragma unroll 1
      for (int j = lo >> 6; j <= cur; ++j) {
        const int nh = (j == cur) ? (((t0 + 15 - 64 * cur) >> 5) + 1) : 2;
#pragma unroll 1
        for (int h = 0; h < nh; ++h)
          att_step<2>(KW + (size_t)(64 * j + 32 * h) * 64, VWT + (size_t)j * 4096 + 32 * h, 64 * j + 32 * h, t, true, qlds,
                      lane, slope, m, ls, O, fr, fq);
      }
    }
    LAUNDER();
#pragma unroll
    for (int r = 0; r < 4; ++r) {
      float lt = ls[r] + shx(ls[r], 16);
      lt += shx(lt, 32);
      const float sc = gsp[r * 3 + 2] / fmaxf(lt, 1e-30f);
#pragma unroll
      for (int dt = 0; dt < 4; ++dt) {
        f32x4* ptr = reinterpret_cast<f32x4*>(onp + r * 64 + dt * 16);
        f32x4 v = *ptr + O[r][dt] * sc;
        ssq += v[0] * v[0] + v[1] * v[1] + v[2] * v[2] + v[3] * v[3];
        *ptr = v;
      }
    }
  }
    LAUNDER();
  ssq += shx(ssq, 16);
  ssq += shx(ssq, 32);
  const float rinv = rsqrtf(ssq * (1.f / 512.f) + EPS);
  const float* gn = p.nsa_out_g + (size_t)l * 512;
#pragma unroll 1
  for (int c = 0; c < 32; ++c) {
    const int cc = c * 16 + fq * 4;
    f32x4 v0 = *reinterpret_cast<const f32x4*>(ONSA + tok * 512 + cc);
    f32x4 g0 = *reinterpret_cast<const f32x4*>(gn + cc);
    st4bf(CAT + tok * 1024 + cc, v0 * g0 * rinv);
  }
}

#undef LAUNDER
__device__ __forceinline__ void ret_kv_task(const P& p, int id) {
  const int lane = tidx() & 63, fr = lane & 15, fq = lane >> 4;
  const int dtile = id & 7, ch = id >> 3;
  const u16* Kt = (const u16*)(p.ws + O_BIG + B_KRT) + (size_t)ch * 16384;
  const u16* Vt = (const u16*)(p.ws + O_BIG + B_VRT) + (size_t)ch * 16384;
  float* KVF = (float*)(p.ws + O_Y) + (size_t)ch * 16384;
  bf16x8 Af[4];
#pragma unroll
  for (int ks = 0; ks < 4; ++ks) Af[ks] = ld8(Kt + (dtile * 16 + fr) * 128 + ks * 32 + fq * 8);
#pragma unroll
  for (int et = 0; et < 8; ++et) {
    f32x4 acc = {0.f, 0.f, 0.f, 0.f};
#pragma unroll
    for (int ks = 0; ks < 4; ++ks) acc = mfma16(Af[ks], ld8(Vt + (et * 16 + fr) * 128 + ks * 32 + fq * 8), acc);
    *reinterpret_cast<f32x4*>(KVF + (et * 16 + fr) * 128 + dtile * 16 + fq * 4) = acc;
  }
}
__device__ __forceinline__ void ret_scan(const P& p) {
  const float* KVF = (const float*)(p.ws + O_Y);
  u16* ST = (u16*)(p.ws + O_Y + 64 * MiB);
  const int gt = bidx() * 512 + tidx(), nt = gdim() * 512;
  for (int idx = gt; idx < 8 * 16384; idx += nt) {
    const int bh = idx >> 14, ed = idx & 16383, h = bh & 3;
    const float cd = exp2f(128.f * ret_lg(h));
    float st = 0.f;
    const size_t base = (size_t)bh * 128 * 16384 + ed;
#pragma unroll 4
    for (int c = 0; c < 128; ++c) {
      ST[base + (size_t)c * 16384] = f2bf(st);
      st = st * cd + KVF[base + (size_t)c * 16384];
    }
  }
}
__device__ __forceinline__ void ret_out_task(const P& p, int l, int id) {
  const int lane = tidx() & 63, fr = lane & 15, fq = lane >> 4;
  const int qtl = id & 7, ch = id >> 3, c = ch & 127, bh = ch >> 7, h = bh & 3, b = bh >> 2;
  unsigned char* big = p.ws + O_BIG;
  const u16* QR = (const u16*)(big + B_QR);
  const u16* KR = (const u16*)(big + B_KR);
  const u16* GR = (const u16*)(big + B_GR);
  const u16* Vt = (const u16*)(big + B_VRT) + (size_t)ch * 16384;
  const u16* ST = (const u16*)(p.ws + O_Y + 64 * MiB) + (size_t)ch * 16384;
  u16* CAT = (u16*)(p.ws + O_HB);
  const size_t tokc = (size_t)b * T + (size_t)c * 128;
  const int n = qtl * 16 + fr;
  const size_t tok = tokc + n;
  const float lg = ret_lg(h);
  bf16x8 Qf[4];
#pragma unroll
  for (int ks = 0; ks < 4; ++ks) Qf[ks] = ld8(QR + tok * 512 + h * 128 + ks * 32 + fq * 8);
  f32x4 O[8];
#pragma unroll
  for (int et = 0; et < 8; ++et) O[et] = f32x4{0.f, 0.f, 0.f, 0.f};
  const int nu = (qtl >> 1) + 1;
  for (int u = 0; u < nu; ++u) {
    f32x4 S[2];
#pragma unroll
    for (int tl = 0; tl < 2; ++tl) {
      const int mt = u * 2 + tl;
      f32x4 z = {0.f, 0.f, 0.f, 0.f};
      const u16* kp = KR + (tokc + mt * 16 + fr) * 512 + h * 128 + fq * 8;
#pragma unroll
      for (int ks = 0; ks < 4; ++ks) z = mfma16(ld8(kp + ks * 32), Qf[ks], z);
#pragma unroll
      for (int i = 0; i < 4; ++i) {
        const int diff = n - (mt * 16 + fq * 4 + i);
        z[i] = diff >= 0 ? z[i] * exp2f((float)diff * lg) : 0.f;
      }
      S[tl] = z;
    }
    bf16x8 Pb = packp(S[0], S[1]);
#pragma unroll
    for (int et = 0; et < 8; ++et) {
      bf16x8 Vf = ld4x2(Vt + (et * 16 + fr) * 128 + u * 32 + fq * 4, Vt + (et * 16 + fr) * 128 + u * 32 + 16 + fq * 4);
      O[et] = mfma16(Vf, Pb, O[et]);
    }
  }
  const float qd = exp2f((float)(n + 1) * lg);
  float s1 = 0.f;
#pragma unroll
  for (int et = 0; et < 8; ++et) {
    f32x4 x = {0.f, 0.f, 0.f, 0.f};
#pragma unroll
    for (int ks = 0; ks < 4; ++ks) x = mfma16(ld8(ST + (et * 16 + fr) * 128 + ks * 32 + fq * 8), Qf[ks], x);
    O[et] += x * qd;
    s1 += O[et][0] + O[et][1] + O[et][2] + O[et][3];
  }
  s1 += shx(s1, 16);
  s1 += shx(s1, 32);
  const float mu = s1 * (1.f / 128.f);
  float s2 = 0.f;
#pragma unroll
  for (int et = 0; et < 8; ++et) {
    O[et] -= mu;
    s2 += O[et][0] * O[et][0] + O[et][1] * O[et][1] + O[et][2] * O[et][2] + O[et][3] * O[et][3];
  }
  s2 += shx(s2, 16);
  s2 += shx(s2, 32);
  const float rinv = rsqrtf(s2 * (1.f / 128.f) + EPS);
  const float* gn = p.ret_gn_g + (size_t)l * 512 + h * 128;
#pragma unroll
  for (int et = 0; et < 8; ++et) {
    const int e = et * 16 + fq * 4;
    f32x4 g = *reinterpret_cast<const f32x4*>(gn + e);
    u32x2 gr = *reinterpret_cast<const u32x2*>(GR + tok * 512 + h * 128 + e);
    f32x4 sg = {bf2f((u16)(gr.x & 0xFFFF)), bf2f((u16)(gr.x >> 16)), bf2f((u16)(gr.y & 0xFFFF)), bf2f((u16)(gr.y >> 16))};
    st4bf(CAT + tok * 1024 + 512 + h * 128 + e, O[et] * rinv * g * sg);
  }
}

__device__ __forceinline__ void xattn_task(const P& p, int id) {
  const int lane = tidx() & 63, fr = lane & 15, fq = lane >> 4;
  const int hd = id & 3, qt = (id >> 2) & 1023, b = id >> 12;
  const u16* QX = (const u16*)(p.ws + O_BIG);
  u16* OX = (u16*)(p.ws + O_BIG + 64 * MiB);
  const u16* KM = (const u16*)(p.ws + O_SMALL + S_KMEM) + (size_t)b * 256 * 1024 + hd * 256;
  const u16* VM = (const u16*)(p.ws + O_SMALL + S_VMEMT) + ((size_t)b * 1024 + hd * 256) * 256;
  const size_t tok = (size_t)b * T + qt * 16 + fr;
  bf16x8 Qf[8];
#pragma unroll
  for (int ks = 0; ks < 8; ++ks) Qf[ks] = ld8(QX + tok * 1024 + hd * 256 + ks * 32 + fq * 8);
  f32x4 S[16];
  float mx = NEG;
#pragma unroll
  for (int mt = 0; mt < 16; ++mt) {
    f32x4 z = {0.f, 0.f, 0.f, 0.f};
    const u16* kp = KM + (size_t)(mt * 16 + fr) * 1024 + fq * 8;
#pragma unroll
    for (int ks = 0; ks < 8; ++ks) z = mfma16(ld8(kp + ks * 32), Qf[ks], z);
    S[mt] = z;
    mx = fmaxf(mx, fmaxf(fmaxf(z[0], z[1]), fmaxf(z[2], z[3])));
  }
  mx = fmaxf(mx, shx(mx, 16));
  mx = fmaxf(mx, shx(mx, 32));
  float sum = 0.f;
#pragma unroll
  for (int mt = 0; mt < 16; ++mt)
#pragma unroll
    for (int i = 0; i < 4; ++i) {
      float e = __expf(S[mt][i] - mx);
      S[mt][i] = e;
      sum += e;
    }
  sum += shx(sum, 16);
  sum += shx(sum, 32);
  const float inv = 1.f / sum;
  bf16x8 Pb[8];
#pragma unroll
  for (int u = 0; u < 8; ++u) Pb[u] = packp(S[2 * u], S[2 * u + 1]);
#pragma unroll
  for (int et = 0; et < 16; ++et) {
    f32x4 o = {0.f, 0.f, 0.f, 0.f};
    const u16* vp = VM + (size_t)(et * 16 + fr) * 256 + fq * 4;
#pragma unroll
    for (int u = 0; u < 8; ++u) o = mfma16(ld4x2(vp + u * 32, vp + u * 32 + 16), Pb[u], o);
    st4bf(OX + tok * 1024 + hd * 256 + et * 16 + fq * 4, o * inv);
  }
}

__device__ __forceinline__ void run_phase(const P& p, int ph, unsigned char* smem) {
  unsigned char* ws = p.ws;
  u16* sm = reinterpret_cast<u16*>(smem);
  u16* HB = (u16*)(ws + O_HB);
  float* Y = (float*)(ws + O_Y);
  unsigned char* big = ws + O_BIG;
  u16* ACT = (u16*)big;
  const int wid = __builtin_amdgcn_readfirstlane(tidx() >> 6);
  const int gw = bidx() * 8 + wid, nw = gdim() * 8;
  const int l = ph == 0 ? 0 : (ph - 1) >> 4;
  const int sub = ph == 0 ? -1 : (ph - 1) & 15;
  const u16* memn = (const u16*)(ws + O_SMALL + S_MEMN) + (size_t)l * 512 * 1024;

  {
    int njobs = 0;
    if (ph == 0) njobs = 3;
    else if (sub == 2 || sub == 8 || sub == 12 || sub == 15) njobs = 1;
    for (int jb = 0; jb < njobs; ++jb) {
      const float *xin = p.out, *y = Y, *gpost = nullptr, *gpre = nullptr;
      float* xout = p.out;
      u16* hb = HB;
      float w = 1.f;
      int ntok = NTOK;
      if (ph == 0) {
        if (jb == 0) { xin = p.x; y = nullptr; gpre = p.ffn1_pre_g; }
        else {
          xin = p.mem; y = nullptr; xout = nullptr; gpre = p.xa_mem_g + (jb - 1) * 1024;
          hb = (u16*)(ws + O_SMALL + S_MEMN) + (size_t)(jb - 1) * 512 * 1024; ntok = 512;
        }
      } else if (sub == 2) { gpost = p.ffn1_post_g + l * 1024; w = 0.5f; gpre = p.mix_pre_g + l * 1024; }
      else if (sub == 8) { gpost = p.mix_post_g + l * 1024; gpre = p.xa_pre_g + l * 1024; }
      else if (sub == 12) { gpost = p.xa_post_g + l * 1024; gpre = p.ffn2_pre_g + l * 1024; }
      else { gpost = p.ffn2_post_g + l * 1024; w = 0.5f; if (l == 0) gpre = p.ffn1_pre_g + 1024; else { gpre = nullptr; hb = nullptr; } }
      norm_phase(xin, y, gpost, w, xout, gpre, hb, ntok);
    }
  }
  if (ph == 0 || (sub == 15 && l == 0)) convert_layer(p, ph == 0 ? 0 : 1, smem);
  if (sub == 0 || sub == 13)
    gemm_phase<EP_SWIGLU>(p, 0, 1.f, ACT, DFF, HB, 1024, (u16*)(ws + (sub == 0 ? W_GU1 : W_GU2)), 1024, NTOK, 5632, 1024, sm,
                          false);
  if (sub == 1 || sub == 7 || sub == 11 || sub == 14) {
    const u16* A = ACT; size_t lda = DFF; const u16* Bt = (u16*)(ws + W_D1); int K = DFF;
    if (sub == 7) { A = HB; lda = 1024; Bt = (u16*)(ws + W_OUT); K = 1024; }
    else if (sub == 11) { A = (const u16*)(big + 64 * MiB); lda = 1024; Bt = (u16*)(ws + W_O); K = 1024; }
    else if (sub == 14) { Bt = (u16*)(ws + W_D2); }
    gemm_phase<EP_F32>(p, 0, 1.f, Y, 1024, A, lda, Bt, (size_t)K, NTOK, 1024, K, sm, false);
  }
  if (sub == 0 || sub == 9) {
    const bool km = (sub == 0);
    gemm_phase<EP_BF16>(p, 0, km ? 1.f : 0.0625f, km ? (void*)(ws + O_SMALL + S_KMEM) : (void*)big, 1024, km ? memn : HB, 1024,
                        (u16*)(ws + (km ? W_K : W_Q)), 1024, km ? 512 : NTOK, 1024, 1024, sm, km);
  }
  if (sub == 0)
    gemm_phase<EP_VMEMT>(p, 0, 1.f, ws + O_SMALL + S_VMEMT, 0, memn, 1024, (u16*)(ws + W_V), 1024, 512, 1024, 1024, sm, true);
  if (sub == 3)
    gemm_phase<EP_WIN>(p, 0, 1.f, nullptr, 0, HB, 1024, (u16*)(ws + W_IN), 1024, NTOK, 3584, 1024, sm, false);
  if (sub == 4) {
    for (int kv = 0; kv < 2; ++kv)
      gemm_phase<EP_C1>(p, kv, 1.f, (u16*)(ws + O_SMALL + S_HC) + (size_t)kv * 4096 * 256, 256,
                        (const u16*)(big + (kv == 0 ? B_KCR : B_VCR)), 1024, (u16*)(ws + W_C1) + (size_t)kv * 256 * 2048, 2048,
                        4096, 256, 2048, sm, kv == 1);
    for (int id = gw; id < 8192; id += nw) ret_kv_task(p, id);
  }
  if (sub == 5) {
    gemm_phase<EP_C2K>(p, 0, 1.f, ws + O_SMALL + S_KCC, 64, (const u16*)(ws + O_SMALL + S_HC), 256, (u16*)(ws + W_C2), 256,
                       4096, 128, 256, sm, false);
    gemm_phase<EP_C2V>(p, 0, 1.f, ws + O_SMALL + S_VCT, 64, (const u16*)(ws + O_SMALL + S_HC) + (size_t)4096 * 256, 256,
                       (u16*)(ws + W_C2) + 128 * 256, 256, 4096, 128, 256, sm, true);
    ret_scan(p);
  }
  if (sub == 6) {
    u32* keys = reinterpret_cast<u32*>(smem) + wid * 16 * KEYSTR;
    for (int id = gw; id < 2048; id += nw) nsa_task(p, l, id & 1, 1023 - (id >> 1), keys);
    for (int id = gw; id < 8192; id += nw) ret_out_task(p, l, id);
  }
  if (sub == 10)
    for (int id = gw; id < 8192; id += nw) xattn_task(p, id);
}

__global__ void __launch_bounds__(512) hymba_mega(P p, int ph0, int ph1) {
  extern __shared__ __attribute__((aligned(16))) unsigned char smem[];
  cg::grid_group grid = cg::this_grid();
  for (int ph = ph0; ph < ph1; ++ph) {
#if defined(__HIP_DEVICE_COMPILE__)
    const __attribute__((address_space(4))) P* pp =
        (const __attribute__((address_space(4))) P*)__builtin_amdgcn_kernarg_segment_ptr();
    asm volatile("" : "+s"(pp));
    P q = *pp;
    run_phase(q, ph, smem);
#endif
    if (ph + 1 < ph1) grid.sync();
  }
}

extern "C" void kernel_launch(void* const* d_in, const int* in_sizes, int n_in, void* d_out, int out_size, void* d_ws,
                              size_t ws_size, hipStream_t stream) {
  P p{};
  const float** pp = reinterpret_cast<const float**>(&p);
  for (int i = 0; i < 28; ++i) pp[i] = (const float*)d_in[i];
  p.out = (float*)d_out;
  p.ws = (unsigned char*)d_ws;
  if (ws_size < WS_NEED) {
    fprintf(stderr, "workspace too small: %zu < %zu\n", ws_size, (size_t)WS_NEED);
    return;
  }
  static int grid_blocks = 0;
  if (!grid_blocks) {
    hipFuncSetAttribute((const void*)hymba_mega, hipFuncAttributeMaxDynamicSharedMemorySize, SMEM_BYTES);
    int dev = 0, cus = 0, per = 0;
    hipGetDevice(&dev);
    hipDeviceGetAttribute(&cus, hipDeviceAttributeMultiprocessorCount, dev);
    hipOccupancyMaxActiveBlocksPerMultiprocessor(&per, hymba_mega, 512, SMEM_BYTES);
    if (per < 1) per = 1;
    grid_blocks = cus * per;
  }
  int ph0 = 0, ph1 = NPH;
  void* args[] = {&p, &ph0, &ph1};
  hipError_t e = hipLaunchCooperativeKernel((void*)hymba_mega, dim3(grid_blocks), dim3(512), args, SMEM_BYTES, stream);
  if (e != hipSuccess) fprintf(stderr, "cooperative launch failed: %s (grid %d)\n", hipGetErrorString(e), grid_blocks);
}
```

```cpp
#include <hip/hip_runtime.h>
#include <hip/hip_cooperative_groups.h>
#include <stdint.h>
#include <stdio.h>
namespace cg = cooperative_groups;

typedef unsigned short u16;
typedef unsigned int u32;
typedef unsigned long long u64;
using bf16x8 = __attribute__((ext_vector_type(8))) short;
using f32x4 = __attribute__((ext_vector_type(4))) float;
using u32x4 = __attribute__((ext_vector_type(4))) unsigned int;
using u32x2 = __attribute__((ext_vector_type(2))) unsigned int;

constexpr int T = 16384, NTOK = 32768, DM = 1024, DFF = 2816;
constexpr int NPH = 33;
constexpr float EPS = 1e-6f;
constexpr float NEG = -1e30f;

constexpr size_t MiB = 1024ull * 1024ull;
constexpr size_t W_GU1 = 0;
constexpr size_t W_D1 = W_GU1 + 5632ull * 1024 * 2;
constexpr size_t W_IN = W_D1 + 1024ull * 2816 * 2;
constexpr size_t W_C1 = W_IN + 3584ull * 1024 * 2;
constexpr size_t W_C2 = W_C1 + 2ull * 256 * 2048 * 2;
constexpr size_t W_OUT = W_C2 + 2ull * 128 * 256 * 2;
constexpr size_t W_Q = W_OUT + 1024ull * 1024 * 2;
constexpr size_t W_K = W_Q + 1024ull * 1024 * 2;
constexpr size_t W_V = W_K + 1024ull * 1024 * 2;
constexpr size_t W_O = W_V + 1024ull * 1024 * 2;
constexpr size_t W_GU2 = W_O + 1024ull * 1024 * 2;
constexpr size_t W_D2 = W_GU2 + 5632ull * 1024 * 2;
constexpr size_t W_BIAS = W_D2 + 1024ull * 2816 * 2;
constexpr size_t W_END = W_BIAS + 16384;
static_assert(W_END <= 56 * MiB, "W region");
constexpr size_t O_HB = 56 * MiB;
constexpr size_t O_Y = O_HB + 64 * MiB;
constexpr size_t O_BIG = O_Y + 128 * MiB;
constexpr size_t SLACK = 4096;
constexpr size_t B_QN = 0;
constexpr size_t B_KCR = B_QN + 32 * MiB;
constexpr size_t B_VCR = B_KCR + 8 * MiB + SLACK;
constexpr size_t B_KS = B_VCR + 8 * MiB + SLACK;
constexpr size_t B_KW = B_KS + 8 * MiB + SLACK;
constexpr size_t B_VST = B_KW + 8 * MiB + SLACK;
constexpr size_t B_VWT = B_VST + 8 * MiB;
constexpr size_t B_GS = B_VWT + 8 * MiB;
constexpr size_t B_QR = B_GS + 3 * MiB;
constexpr size_t B_KR = B_QR + 32 * MiB;
constexpr size_t B_GR = B_KR + 32 * MiB;
constexpr size_t B_KRT = B_GR + 32 * MiB;
constexpr size_t B_VRT = B_KRT + 32 * MiB;
constexpr size_t B_END = B_VRT + 32 * MiB;
static_assert(B_END <= 244 * MiB, "BIG region");
constexpr size_t O_SMALL = O_BIG + 244 * MiB;
constexpr size_t S_HC = 0;
constexpr size_t S_KCC = S_HC + 4 * MiB;
constexpr size_t S_VCT = S_KCC + 512 * 1024;
constexpr size_t S_MEMN = S_VCT + 512 * 1024;
constexpr size_t S_KMEM = S_MEMN + 2 * MiB;
constexpr size_t S_VMEMT = S_KMEM + 1 * MiB;
constexpr size_t S_BAR = S_VMEMT + 1 * MiB;
constexpr size_t S_END = S_BAR + 16384;
constexpr size_t WS_NEED = O_SMALL + S_END;
static_assert(WS_NEED <= 512 * MiB, "workspace");

constexpr int KEYSTR = 260;
constexpr int SMEM_BYTES = 8 * 16 * KEYSTR * 4;
constexpr int LDSS = 72;

struct P {
  const float *x, *mem, *ffn1_pre_g, *ffn1_wg, *ffn1_wu, *ffn1_wd, *ffn1_post_g, *mix_pre_g, *w_in, *cmp_pe,
      *cmp_w1, *cmp_w2, *nsa_out_g, *ret_gn_g, *w_out, *mix_post_g, *xa_pre_g, *xa_mem_g, *xa_wq, *xa_wk, *xa_wv,
      *xa_wo, *xa_post_g, *ffn2_pre_g, *ffn2_wg, *ffn2_wu, *ffn2_wd, *ffn2_post_g;
  float* out;
  unsigned char* ws;
};

__device__ __forceinline__ u16 f2bf(float f) {
  u32 u = __float_as_uint(f);
  u += 0x7FFFu + ((u >> 16) & 1u);
  return (u16)(u >> 16);
}
__device__ __forceinline__ float bf2f(u16 h) { return __uint_as_float(((u32)h) << 16); }
typedef __bf16 bf16v2_t __attribute__((ext_vector_type(2)));
typedef float f32x2_t __attribute__((ext_vector_type(2)));
__device__ __forceinline__ u32 pack2(float a, float b) {
  f32x2_t v = {a, b};
  bf16v2_t h = __builtin_convertvector(v, bf16v2_t);
  return __builtin_bit_cast(u32, h);
}
__device__ __forceinline__ float silu_f(float v) { return v * __builtin_amdgcn_rcpf(1.f + __expf(-v)); }
__device__ __forceinline__ float sigm_f(float v) { return __builtin_amdgcn_rcpf(1.f + __expf(-v)); }
__device__ __forceinline__ float shx(float v, int m) { return __shfl_xor(v, m, 64); }
__device__ __forceinline__ float wave_sum(float v) {
#pragma unroll
  for (int o = 32; o >= 1; o >>= 1) v += __shfl_xor(v, o, 64);
  return v;
}
__device__ __forceinline__ f32x4 mfma16(bf16x8 a, bf16x8 b, f32x4 c) {
  return __builtin_amdgcn_mfma_f32_16x16x32_bf16(a, b, c, 0, 0, 0);
}
__device__ __forceinline__ bf16x8 ld8(const u16* p) { return *reinterpret_cast<const bf16x8*>(p); }
__device__ __forceinline__ bf16x8 ld4x2(const u16* p0, const u16* p1) {
  u32x2 a = *reinterpret_cast<const u32x2*>(p0);
  u32x2 b = *reinterpret_cast<const u32x2*>(p1);
  u32x4 r = {a.x, a.y, b.x, b.y};
  return __builtin_bit_cast(bf16x8, r);
}
__device__ __forceinline__ bf16x8 packp(f32x4 a, f32x4 b) {
  u32x4 r = {pack2(a[0], a[1]), pack2(a[2], a[3]), pack2(b[0], b[1]), pack2(b[2], b[3])};
  return __builtin_bit_cast(bf16x8, r);
}
__device__ __forceinline__ void st4bf(u16* p, f32x4 v) {
  u32x2 r = {pack2(v[0], v[1]), pack2(v[2], v[3])};
  *reinterpret_cast<u32x2*>(p) = r;
}
__device__ __forceinline__ f32x4 bf4_to_f32(u32x2 r) {
  return f32x4{__uint_as_float(r.x << 16), __uint_as_float(r.x & 0xFFFF0000u), __uint_as_float(r.y << 16), __uint_as_float(r.y & 0xFFFF0000u)};
}
__device__ __forceinline__ float ret_lg(int h) { return log2f(1.f - exp2f(-5.f - (float)h)); }

__device__ __forceinline__ int tidx() {
  int t = threadIdx.x;
  asm volatile("" : "+v"(t));
  return t;
}
__device__ __forceinline__ int bidx() {
  int t = blockIdx.x;
  asm volatile("" : "+s"(t));
  return t;
}
__device__ __forceinline__ int gdim() {
  int t = gridDim.x;
  asm volatile("" : "+s"(t));
  return t;
}
__device__ __forceinline__ int wmap(int mode, int n) {
  if (mode == 1) return (n >> 7) * 256 + (n & 127);
  if (mode == 2) return (n >> 7) * 256 + 128 + (n & 127);
  if (mode == 3) return n < 1280 ? n : (n < 1304 ? 3328 + (n - 1280) : n - 24);
  return n;
}
__device__ __forceinline__ void tconv(const float* __restrict__ src, int K, int N, u16* __restrict__ dst, int mode, int& tbase,
                      float* tile) {
  const int nkt = K >> 6, nnt = (N + 63) >> 6, ntl = nkt * nnt;
  const int G = gdim();
  int tl0 = (bidx() - (tbase % G) + G) % G;
  const int tid = tidx();
  for (int tl = tl0; tl < ntl; tl += G) {
    const int k0 = (tl / nnt) << 6, n0 = (tl % nnt) << 6;
#pragma unroll
    for (int i = 0; i < 2; ++i) {
      const int kk = (tid >> 4) + i * 32, nn = (tid & 15) * 4;
      f32x4 v = {0.f, 0.f, 0.f, 0.f};
      if (n0 + nn < N) v = *reinterpret_cast<const f32x4*>(src + (size_t)(k0 + kk) * N + n0 + nn);
      tile[kk * 65 + nn + 0] = v[0];
      tile[kk * 65 + nn + 1] = v[1];
      tile[kk * 65 + nn + 2] = v[2];
      tile[kk * 65 + nn + 3] = v[3];
    }
    __syncthreads();
    {
      int nn = tid >> 3, ch = tid & 7;
      if (n0 + nn < N) {
        u32x4 r;
        r.x = pack2(tile[(ch * 8 + 0) * 65 + nn], tile[(ch * 8 + 1) * 65 + nn]);
        r.y = pack2(tile[(ch * 8 + 2) * 65 + nn], tile[(ch * 8 + 3) * 65 + nn]);
        r.z = pack2(tile[(ch * 8 + 4) * 65 + nn], tile[(ch * 8 + 5) * 65 + nn]);
        r.w = pack2(tile[(ch * 8 + 6) * 65 + nn], tile[(ch * 8 + 7) * 65 + nn]);
        *reinterpret_cast<u32x4*>(dst + (size_t)wmap(mode, n0 + nn) * K + k0 + ch * 8) = r;
      }
    }
    __syncthreads();
  }
  tbase += ntl;
}

__device__ __forceinline__ void convert_layer(const P& p, int l, unsigned char* smem) {
  float* tile = reinterpret_cast<float*>(smem);
  unsigned char* W = p.ws;
  int tb = 0;
  tconv(p.ffn1_wg + (size_t)l * DM * DFF, DM, DFF, (u16*)(W + W_GU1), 1, tb, tile);
  tconv(p.ffn1_wu + (size_t)l * DM * DFF, DM, DFF, (u16*)(W + W_GU1), 2, tb, tile);
  tconv(p.ffn1_wd + (size_t)l * DFF * DM, DFF, DM, (u16*)(W + W_D1), 0, tb, tile);
  tconv(p.w_in + (size_t)l * DM * 3352, DM, 3352, (u16*)(W + W_IN), 3, tb, tile);
  tconv(p.cmp_w1 + (size_t)(l * 2 + 0) * 2048 * 256, 2048, 256, (u16*)(W + W_C1), 0, tb, tile);
  tconv(p.cmp_w1 + (size_t)(l * 2 + 1) * 2048 * 256, 2048, 256, (u16*)(W + W_C1) + 256 * 2048, 0, tb, tile);
  tconv(p.cmp_w2 + (size_t)(l * 2 + 0) * 256 * 64, 256, 64, (u16*)(W + W_C2), 0, tb, tile);
  tconv(p.cmp_w2 + (size_t)(l * 2 + 1) * 256 * 64, 256, 64, (u16*)(W + W_C2) + 128 * 256, 0, tb, tile);
  tconv(p.w_out + (size_t)l * DM * DM, DM, DM, (u16*)(W + W_OUT), 0, tb, tile);
  tconv(p.xa_wq + (size_t)l * DM * DM, DM, DM, (u16*)(W + W_Q), 0, tb, tile);
  tconv(p.xa_wk + (size_t)l * DM * DM, DM, DM, (u16*)(W + W_K), 0, tb, tile);
  tconv(p.xa_wv + (size_t)l * DM * DM, DM, DM, (u16*)(W + W_V), 0, tb, tile);
  tconv(p.xa_wo + (size_t)l * DM * DM, DM, DM, (u16*)(W + W_O), 0, tb, tile);
  tconv(p.ffn2_wg + (size_t)l * DM * DFF, DM, DFF, (u16*)(W + W_GU2), 1, tb, tile);
  tconv(p.ffn2_wu + (size_t)l * DM * DFF, DM, DFF, (u16*)(W + W_GU2), 2, tb, tile);
  tconv(p.ffn2_wd + (size_t)l * DFF * DM, DFF, DM, (u16*)(W + W_D2), 0, tb, tile);
  const int gt = bidx() * 512 + tidx(), nt = gdim() * 512;
  {
    u32* z = reinterpret_cast<u32*>((u16*)(W + W_IN) + (size_t)3352 * 1024);
    for (int i = gt; i < 232 * 512; i += nt) z[i] = 0u;
    for (int kv = 0; kv < 2; ++kv) {
      u32* z2 = reinterpret_cast<u32*>((u16*)(W + W_C2) + (size_t)kv * 128 * 256 + 64 * 256);
      for (int i = gt; i < 64 * 128; i += nt) z2[i] = 0u;
    }
  }
  {
    float* red = reinterpret_cast<float*>(smem);
    const int tid = tidx(), kg = tid >> 6, cl = tid & 63;
    for (int job = gdim() - 1 - bidx(); job < 64; job += gdim()) {
      const int kv = job >> 5, ct = (job >> 3) & 3, kb = job & 7;
      const float* pe = p.cmp_pe + (size_t)(l * 2 + kv) * 2048 + kb * 256 + kg * 32;
      const float* w1 = p.cmp_w1 + ((size_t)(l * 2 + kv) * 2048 + kb * 256 + kg * 32) * 256 + ct * 64 + cl;
      float s = 0.f;
#pragma unroll 8
      for (int i = 0; i < 32; ++i) s += pe[i] * w1[(size_t)i * 256];
      __syncthreads();
      red[kg * 64 + cl] = s;
      __syncthreads();
      if (tid < 64) {
        float a = 0.f;
#pragma unroll
        for (int j = 0; j < 8; ++j) a += red[j * 64 + tid];
        reinterpret_cast<float*>(W + W_BIAS)[(kv * 8 + kb) * 256 + ct * 64 + tid] = a;
      }
    }
    __syncthreads();
  }
}

__device__ __forceinline__ void bf8_to_f32(u32x4 r, f32x4& a, f32x4& b) {
  a = f32x4{__uint_as_float(r.x << 16), __uint_as_float(r.x & 0xFFFF0000u), __uint_as_float(r.y << 16), __uint_as_float(r.y & 0xFFFF0000u)};
  b = f32x4{__uint_as_float(r.z << 16), __uint_as_float(r.z & 0xFFFF0000u), __uint_as_float(r.w << 16), __uint_as_float(r.w & 0xFFFF0000u)};
}
__device__ __forceinline__ void st8bf_n(u16* p, f32x4 a, f32x4 b) {
  u32x4 r = {pack2(a[0], a[1]), pack2(a[2], a[3]), pack2(b[0], b[1]), pack2(b[2], b[3])};
  *reinterpret_cast<u32x4*>(p) = r;
}
__device__ __forceinline__ void norm_phase(const float* __restrict__ xin_f, const u16* __restrict__ xin_b, const u16* __restrict__ y,
                                           const float* __restrict__ gpost, float w, u16* __restrict__ xout_b,
                                           float* __restrict__ xout_f, float* __restrict__ xout_f2,
                                           const float* __restrict__ gpre, u16* __restrict__ hb, int ntok) {
  const int lane = tidx() & 63;
  const int gw = bidx() * 8 + __builtin_amdgcn_readfirstlane(tidx() >> 6), nw = gdim() * 8;
  for (int tok = gw; tok < ntok; tok += nw) {
    f32x4 xv[4];
    if (xin_b) {
#pragma unroll
      for (int i = 0; i < 2; ++i) {
        u32x4 xr = *reinterpret_cast<const u32x4*>(xin_b + (size_t)tok * 1024 + i * 512 + lane * 8);
        bf8_to_f32(xr, xv[2 * i], xv[2 * i + 1]);
      }
    } else {
#pragma unroll
      for (int i = 0; i < 2; ++i) {
        xv[2 * i] = *reinterpret_cast<const f32x4*>(xin_f + (size_t)tok * 1024 + i * 512 + lane * 8);
        xv[2 * i + 1] = *reinterpret_cast<const f32x4*>(xin_f + (size_t)tok * 1024 + i * 512 + lane * 8 + 4);
      }
    }
    if (y) {
      f32x4 yv[4];
      float ss = 0.f;
#pragma unroll
      for (int i = 0; i < 2; ++i) {
        u32x4 yr = *reinterpret_cast<const u32x4*>(y + (size_t)tok * 1024 + i * 512 + lane * 8);
        bf8_to_f32(yr, yv[2 * i], yv[2 * i + 1]);
      }
#pragma unroll
      for (int q = 0; q < 4; ++q) ss += yv[q][0] * yv[q][0] + yv[q][1] * yv[q][1] + yv[q][2] * yv[q][2] + yv[q][3] * yv[q][3];
      ss = wave_sum(ss);
      float r = rsqrtf(ss * (1.f / 1024.f) + EPS) * w;
#pragma unroll
      for (int q = 0; q < 4; ++q) {
        f32x4 g = *reinterpret_cast<const f32x4*>(gpost + (q >> 1) * 512 + lane * 8 + (q & 1) * 4);
        xv[q] += yv[q] * g * r;
      }
    }
    if (xout_b) {
#pragma unroll
      for (int i = 0; i < 2; ++i) st8bf_n(xout_b + (size_t)tok * 1024 + i * 512 + lane * 8, xv[2 * i], xv[2 * i + 1]);
    }
    if (xout_f) {
      float* o = (tok < 16384 ? xout_f : xout_f2) + (size_t)tok * 1024;
#pragma unroll
      for (int q = 0; q < 4; ++q) *reinterpret_cast<f32x4*>(o + (q >> 1) * 512 + lane * 8 + (q & 1) * 4) = xv[q];
    }
    if (hb) {
      float ss = 0.f;
#pragma unroll
      for (int q = 0; q < 4; ++q) ss += xv[q][0] * xv[q][0] + xv[q][1] * xv[q][1] + xv[q][2] * xv[q][2] + xv[q][3] * xv[q][3];
      ss = wave_sum(ss);
      float r = rsqrtf(ss * (1.f / 1024.f) + EPS);
      f32x4 hv[4];
#pragma unroll
      for (int q = 0; q < 4; ++q) {
        f32x4 g = *reinterpret_cast<const f32x4*>(gpre + (q >> 1) * 512 + lane * 8 + (q & 1) * 4);
        hv[q] = xv[q] * g * r;
      }
#pragma unroll
      for (int i = 0; i < 2; ++i) st8bf_n(hb + (size_t)tok * 1024 + i * 512 + lane * 8, hv[2 * i], hv[2 * i + 1]);
    }
  }
}

enum { EP_SWIGLU = 0, EP_F32 = 1, EP_WIN = 2, EP_C1 = 3, EP_C2K = 4, EP_C2V = 5, EP_BF16 = 6, EP_VMEMT = 7 };

template <int MODE>
__device__ __forceinline__ void epi_store(const P& p, int aux, float scale, void* outp, int ldo, int row, int col,
                                          f32x4 v) {
  unsigned char* ws = p.ws;
  if constexpr (MODE == EP_F32) {
    float* o = (float*)outp;
#pragma unroll
    for (int i = 0; i < 4; ++i) o[(size_t)(row + i) * ldo + col] = v[i];
  } else if constexpr (MODE == EP_BF16) {
    u16* o = (u16*)outp;
#pragma unroll
    for (int i = 0; i < 4; ++i) o[(size_t)(row + i) * ldo + col] = f2bf(v[i] * scale);
  } else if constexpr (MODE == EP_C1) {
    u16* o = (u16*)outp;
    float bia = 0.f;
#pragma unroll
    for (int j = 0; j < 8; ++j) bia += reinterpret_cast<const float*>(ws + W_BIAS)[(aux * 8 + j) * 256 + col];
#pragma unroll
    for (int i = 0; i < 4; ++i) o[(size_t)(row + i) * 256 + col] = f2bf(silu_f(v[i] + bia));
  } else if constexpr (MODE == EP_C2K) {
    if (col < 64) {
      u16* o = (u16*)outp;
#pragma unroll
      for (int i = 0; i < 4; ++i) o[(size_t)(row + i) * 64 + col] = f2bf(v[i]);
    }
  } else if constexpr (MODE == EP_C2V) {
    if (col < 64) {
      u16* o = (u16*)outp;
      int bg = row >> 10, n = row & 1023;
      st4bf(o + (size_t)bg * 65536 + (size_t)(n >> 6) * 4096 + col * 64 + (n & 63), v);
    }
  } else if constexpr (MODE == EP_VMEMT) {
    u16* o = (u16*)outp;
    int b = row >> 8, m = row & 255;
    st4bf(o + ((size_t)b * 1024 + col) * 256 + m, v);
  } else if constexpr (MODE == EP_WIN) {
    unsigned char* big = ws + O_BIG;
    const int b = row >> 14, t = row & 16383;
    if (col < 512) {
      u16* o = (u16*)(big + B_QN);
#pragma unroll
      for (int i = 0; i < 4; ++i) o[(size_t)(row + i) * 512 + col] = f2bf(v[i] * 0.125f);
    } else if (col < 1280) {
      const int s = (col - 512) >> 7, cc = (col - 512) & 127, g = cc >> 6, d = cc & 63, bg = b * 2 + g;
      if (s == 3 || s == 5) {
        u16* o = (u16*)(big + (s == 3 ? B_VST : B_VWT));
        st4bf(o + ((size_t)(bg * 256 + (t >> 6)) * 4096 + d * 64 + (t & 63)), v);
      } else {
        u16* o = (u16*)(big + (s == 0 ? B_KCR : (s == 1 ? B_VCR : (s == 2 ? B_KS : B_KW))));
        o += ((size_t)bg * T + t) * 64 + d;
#pragma unroll
        for (int i = 0; i < 4; ++i) o[i * 64] = f2bf(v[i]);
      }
    } else if (col < 3328) {
      const int cr = col - 1280, wh = cr >> 9, cc = cr & 511, h = cc >> 7, d = cc & 127;
      const float s128 = 0.08838834764831845f;
      if (wh == 0) {
        u16* o = (u16*)(big + B_QR);
#pragma unroll
        for (int i = 0; i < 4; ++i) o[(size_t)(row + i) * 512 + cc] = f2bf(v[i]);
      } else if (wh == 1) {
        u16* o = (u16*)(big + B_KR);
#pragma unroll
        for (int i = 0; i < 4; ++i) o[(size_t)(row + i) * 512 + cc] = f2bf(v[i] * s128);
        u16* ot = (u16*)(big + B_KRT);
        const float lg = ret_lg(h);
        const int tm = t & 127;
        f32x4 w;
#pragma unroll
        for (int i = 0; i < 4; ++i) w[i] = v[i] * s128 * exp2f((float)(127 - tm - i) * lg);
        st4bf(ot + ((size_t)((b * 4 + h) * 128 + (t >> 7)) * 16384 + d * 128 + tm), w);
      } else if (wh == 2) {
        u16* ot = (u16*)(big + B_VRT);
        st4bf(ot + ((size_t)((b * 4 + h) * 128 + (t >> 7)) * 16384 + d * 128 + (t & 127)), v);
      } else {
        u16* o = (u16*)(big + B_GR);
#pragma unroll
        for (int i = 0; i < 4; ++i) o[(size_t)(row + i) * 512 + cc] = f2bf(silu_f(v[i]));
      }
    } else if (col < 3352) {
      float* o = (float*)(big + B_GS);
#pragma unroll
      for (int i = 0; i < 4; ++i) o[(size_t)(row + i) * 24 + (col - 3328)] = sigm_f(v[i]);
    }
  }
}

template <int MODE>
__device__ __forceinline__ void gemm_tile(const P& p, int aux, float scale, void* outp, int ldo, const u16* __restrict__ A, size_t lda,
                          const u16* __restrict__ Bt, size_t ldb, int K, int brow, int bcol, u16* sm) {
  const int tid = tidx(), lane = tid & 63, wid = __builtin_amdgcn_readfirstlane(tid >> 6);
  const int wr = wid >> 1, wc = wid & 1, fr = lane & 15, fq = lane >> 4;
  u16* smA = sm;
  u16* smB = sm + 2 * 256 * LDSS;
  f32x4 acc[4][4];
#pragma unroll
  for (int m = 0; m < 4; ++m)
#pragma unroll
    for (int n = 0; n < 4; ++n) acc[m][n] = f32x4{0.f, 0.f, 0.f, 0.f};
  u32x4 ra[4], rb[2];
  const int nt = K >> 6;
  auto gload = [&](int kt) {
#pragma unroll
    for (int i = 0; i < 4; ++i) {
      int c = tid + i * 512;
      ra[i] = *reinterpret_cast<const u32x4*>(A + (size_t)(brow + (c >> 3)) * lda + (size_t)kt * 64 + (c & 7) * 8);
    }
#pragma unroll
    for (int i = 0; i < 2; ++i) {
      int c = tid + i * 512;
      rb[i] = *reinterpret_cast<const u32x4*>(Bt + (size_t)(bcol + (c >> 3)) * ldb + (size_t)kt * 64 + (c & 7) * 8);
    }
  };
  auto swrite = [&](int buf) {
#pragma unroll
    for (int i = 0; i < 4; ++i) {
      int c = tid + i * 512;
      *reinterpret_cast<u32x4*>(smA + buf * 256 * LDSS + (c >> 3) * LDSS + (c & 7) * 8) = ra[i];
    }
#pragma unroll
    for (int i = 0; i < 2; ++i) {
      int c = tid + i * 512;
      *reinterpret_cast<u32x4*>(smB + buf * 128 * LDSS + (c >> 3) * LDSS + (c & 7) * 8) = rb[i];
    }
  };
  gload(0);
  swrite(0);
  __syncthreads();
  for (int kt = 0; kt < nt; ++kt) {
    const int buf = kt & 1;
    if (kt + 1 < nt) gload(kt + 1);
    const u16* a0 = smA + buf * 256 * LDSS + (wr * 64 + fr) * LDSS + fq * 8;
    const u16* b0 = smB + buf * 128 * LDSS + (wc * 64 + fr) * LDSS + fq * 8;
#pragma unroll
    for (int ks = 0; ks < 2; ++ks) {
      bf16x8 af[4], bfr[4];
#pragma unroll
      for (int m = 0; m < 4; ++m) af[m] = ld8(a0 + m * 16 * LDSS + ks * 32);
#pragma unroll
      for (int n = 0; n < 4; ++n) bfr[n] = ld8(b0 + n * 16 * LDSS + ks * 32);
#pragma unroll
      for (int m = 0; m < 4; ++m)
#pragma unroll
        for (int n = 0; n < 4; ++n) acc[m][n] = mfma16(af[m], bfr[n], acc[m][n]);
    }
    if (kt + 1 < nt) swrite(buf ^ 1);
    __syncthreads();
  }
#pragma unroll
  for (int m = 0; m < 4; ++m) {
    const int row = brow + wr * 64 + m * 16 + fq * 4;
    if constexpr (MODE == EP_SWIGLU) {
#pragma unroll
      for (int n = 0; n < 4; n += 2) {
        const int cb = bcol + wc * 64 + n * 16;
        const int oc = (cb >> 5) * 16 + fr;
        u16* o = (u16*)outp;
#pragma unroll
        for (int i = 0; i < 4; ++i)
          o[(size_t)(row + i) * DFF + oc] = f2bf(silu_f(acc[m][n][i]) * acc[m][n + 1][i]);
      }
    } else {
#pragma unroll
      for (int n = 0; n < 4; ++n)
        epi_store<MODE>(p, aux, scale, outp, ldo, row, bcol + wc * 64 + n * 16 + fr, acc[m][n]);
    }
  }
}

template <int MODE>
__device__ __forceinline__ void gemm_phase(const P& p, int aux, float scale, void* outp, int ldo, const u16* A, size_t lda,
                           const u16* Bt, size_t ldb, int M, int N, int K, u16* sm, int rev) {
  const int nNt = N >> 7, ntl = (M >> 8) * nNt;
  const int bid = (bidx() + gdim() - rev) % gdim();
  for (int tl = bid; tl < ntl; tl += gdim())
    gemm_tile<MODE>(p, aux, scale, outp, ldo, A, lda, Bt, ldb, K, (tl / nNt) << 8, (tl % nNt) << 7, sm);
}

namespace pg8 {
#define PG8_LAS __attribute__((address_space(3)))
typedef unsigned short bf16_t;
typedef short bf16x8 __attribute__((ext_vector_type(8)));
typedef float f32x4 __attribute__((ext_vector_type(4)));
typedef unsigned u32x4 __attribute__((ext_vector_type(4)));
constexpr int BM = 256, BK = 64, HALF = 128, HTB = HALF * BK * 2  , STAGE_BYTES = 8 * HTB, NXCD = 8, WGM = 8;

__host__ __device__ __forceinline__ int lds_byte(int r, int c) { const int st = (r >> 4) * 2 + (c >> 5), rr = r & 15, cc = c & 31, ob = rr * 64 + cc * 2; return st * 1024 + (ob ^ (((ob >> 9) & 1) << 5)); }
__host__ __device__ __forceinline__ void stage_rc(int b, int& R, int& C) { const int st = b / 1024, sb = b % 1024, swz = sb ^ (((sb >> 9) & 1) << 5); R = (st >> 1) * 16 + swz / 64; C = (st & 1) * 32 + (swz % 64) / 2; }
__host__ __device__ __forceinline__ int perm32(int rho) { const int n = rho >> 4, i = rho & 15; return 8 * (i >> 2) + 4 * n + (i & 3); }

struct Unit { int pm, pn; };
struct Gemm { const bf16_t* A; const bf16_t* Bt; int M, N, K, lda, ldb; };

struct StaticOrder {
    int nM, nN, nwg, G, c;
    __host__ __device__ void init(int M, int N, int G_, int c_) { nM = M / BM; nN = N / BM; nwg = nM * nN; G = G_; c = c_; }
    __host__ __device__ bool next(int i, Unit& u) const {
        const long L = (long)i * G + c; if (L >= nwg) return false;
        int wgid = (int)L; { const int q = nwg / NXCD, r = nwg % NXCD, xcd = wgid % NXCD, off = wgid / NXCD; wgid = (xcd < r ? xcd * (q + 1) : r * (q + 1) + (xcd - r) * q) + off; }
        const int nig = WGM * nN, gid = wgid / nig, fm = gid * WGM, gsz = (nM - fm) < WGM ? (nM - fm) : WGM;
        u.pm = fm + ((wgid % nig) % gsz); u.pn = (wgid % nig) / gsz; return true;
    }
    __device__ __forceinline__ void a_ready(const Unit&) const {}
    __device__ __forceinline__ void done(const Unit&) const {}
};
__device__ __forceinline__ unsigned cvt_pk_bf16(float lo, float hi) { unsigned r; asm volatile("v_cvt_pk_bf16_f32 %0, %1, %2" : "=v"(r) : "v"(lo), "v"(hi)); return r; }
template <class Epi, class Sched, bool STAMP = false>
__device__ __forceinline__ void gemm_phase(PG8_LAS unsigned char* lds, const Gemm g, const Sched& S, const Epi& E, unsigned long long* stamps) {
    const int tid = tidx(), wid = __builtin_amdgcn_readfirstlane(tid >> 6), lane = tid & 63, wr = wid >> 2, wc = wid & 3, fr = lane & 15, fq = lane >> 4;
    const int K = g.K, nt = K / BK;
    int ts_lo = 0, ts_hi = 0, nts = 0; const unsigned long long rt_entry = STAMP ? (unsigned long long)wall_clock64() : 0ull;
#define PG8_STAMP() do { if (STAMP && wid == 0 && nts < 64) { const unsigned long long _c = (unsigned long long)clock64(); \
        ts_lo = (lane == nts) ? (int)(unsigned)_c : ts_lo; ts_hi = (lane == nts) ? (int)(unsigned)(_c >> 32) : ts_hi; ++nts; } } while (0)
    PG8_STAMP();
    unsigned voffA[2], voffB[2];
#pragma unroll
    for (int i = 0; i < 2; ++i) { int R, C; stage_rc(tid * 16 + i * 8192, R, C); const int Rb = Epi::PERM ? ((R & ~31) + perm32(R & 31)) : R;
        voffA[i] = (unsigned)(R * g.lda + C) * 2u; voffB[i] = (unsigned)(Rb * g.ldb + C) * 2u; }
    const size_t kstep = (size_t)(BK * 2);
    const size_t hstepA = (size_t)HALF * g.lda * 2, hstepB = (size_t)HALF * g.ldb * 2;
    const size_t tstepA = 2 * hstepA, tstepB = 2 * hstepB;
    const unsigned ldsw = (unsigned)wid * 1024u;
    const int aoff = lds_byte(wr * 64 + fr, fq * 8), boff = lds_byte(wc * 32 + fr, fq * 8);
#define PG8_SA(b, h) (((b) * 2 + (h)) * HTB)
#define PG8_SB(b, h) ((4 + (b) * 2 + (h)) * HTB)
#define PG8_STAGE(bufoff, gbase, voff) do { _Pragma("unroll") for (int _i = 0; _i < 2; ++_i) \
        __builtin_amdgcn_global_load_lds((const unsigned*)((const char*)(gbase) + (voff)[_i]), (PG8_LAS unsigned*)(lds + (bufoff) + ldsw + _i * 8192), 16, 0, 0); } while (0)
#define PG8_LDA(dst, b, h) do { _Pragma("unroll") for (int m = 0; m < 4; ++m) _Pragma("unroll") for (int k = 0; k < 2; ++k) dst[m][k] = *(const PG8_LAS bf16x8*)(lds + PG8_SA(b, h) + aoff + m * 2048 + k * 1024); } while (0)
#define PG8_LDB(dst, b, h) do { _Pragma("unroll") for (int n = 0; n < 2; ++n) _Pragma("unroll") for (int k = 0; k < 2; ++k) dst[n][k] = *(const PG8_LAS bf16x8*)(lds + PG8_SB(b, h) + boff + n * 2048 + k * 1024); } while (0)
#define PG8_MMA(ai, bj, At, Bt) do { __builtin_amdgcn_s_setprio(1); _Pragma("unroll") for (int m = 0; m < 4; ++m) _Pragma("unroll") for (int n = 0; n < 2; ++n) _Pragma("unroll") for (int k = 0; k < 2; ++k) \
        acc[ai][bj][m][n] = __builtin_amdgcn_mfma_f32_16x16x32_bf16(Bt[n][k], At[m][k], acc[ai][bj][m][n], 0, 0, 0); __builtin_amdgcn_s_setprio(0); } while (0)
#define PG8_WAIT_V(n) asm volatile("s_waitcnt vmcnt(" #n ")" ::: "memory")
#define PG8_WAIT_L(n) asm volatile("s_waitcnt lgkmcnt(" #n ")" ::: "memory")
#define PG8_BAR __builtin_amdgcn_s_barrier()
#define PG8_SCHED __builtin_amdgcn_sched_barrier(0)
    Unit cur, nxt; int ui = 0;
    if (!S.next(0, cur)) return;
    f32x4 acc[2][2][4][2];
#pragma unroll
    for (int a = 0; a < 2; ++a)
#pragma unroll
        for (int b = 0; b < 2; ++b)
#pragma unroll
            for (int m = 0; m < 4; ++m)
#pragma unroll
                for (int n = 0; n < 2; ++n) acc[a][b][m][n] = (f32x4){0.f, 0.f, 0.f, 0.f};
    bf16x8 At[4][2], B0[2][2], B1[2][2];
    const char* cA = (const char*)g.A + (size_t)cur.pm * tstepA; const char* cB = (const char*)g.Bt + (size_t)cur.pn * tstepB;
    S.a_ready(cur);
    PG8_STAGE(PG8_SB(0, 0), cB, voffB); PG8_STAGE(PG8_SA(0, 0), cA, voffA); PG8_STAGE(PG8_SB(0, 1), cB + hstepB, voffB); PG8_STAGE(PG8_SA(0, 1), cA + hstepA, voffA);
    if (wr == 1) PG8_BAR;
    PG8_WAIT_V(4); PG8_BAR;
    PG8_STAGE(PG8_SB(1, 0), cB + kstep, voffB); PG8_STAGE(PG8_SA(1, 0), cA + kstep, voffA); PG8_STAGE(PG8_SB(1, 1), cB + hstepB + kstep, voffB);
    PG8_WAIT_V(6); PG8_BAR;
    PG8_STAMP();
    for (;;) {
        const bool has_next = S.next(ui + 1, nxt);
        const char* nA = has_next ? (const char*)g.A + (size_t)nxt.pm * tstepA : cA; const char* nB = has_next ? (const char*)g.Bt + (size_t)nxt.pn * tstepB : cB;
        for (int t = 0; t < nt; t += 2) {
            const bool last = (t == nt - 2);
            const char* a1 = cA + (size_t)(t + 1) * kstep;
            const char* a2 = last ? nA : cA + (size_t)(t + 2) * kstep; const char* b2 = last ? nB : cB + (size_t)(t + 2) * kstep;
            const char* a3 = a2 + kstep; const char* b3 = b2 + kstep;
            if (last && has_next) S.a_ready(nxt);
            PG8_LDB(B0, 0, 0); PG8_SCHED; PG8_LDA(At, 0, 0); PG8_STAGE(PG8_SA(1, 1), a1 + hstepA, voffA);
            PG8_WAIT_L(8); PG8_BAR; PG8_WAIT_L(0); PG8_MMA(0, 0, At, B0); PG8_BAR; PG8_SCHED;
            PG8_LDB(B1, 0, 1); PG8_STAGE(PG8_SB(0, 0), b2, voffB);
            PG8_BAR; PG8_WAIT_L(0); PG8_MMA(0, 1, At, B1); PG8_BAR;
            PG8_LDA(At, 0, 1); PG8_STAGE(PG8_SA(0, 0), a2, voffA);
            PG8_BAR; PG8_WAIT_L(0); PG8_MMA(1, 0, At, B0); PG8_BAR; PG8_SCHED;
            PG8_STAGE(PG8_SB(0, 1), b2 + hstepB, voffB);
            PG8_WAIT_V(6); PG8_BAR; PG8_MMA(1, 1, At, B1); PG8_BAR;
            PG8_LDB(B0, 1, 0); PG8_SCHED; PG8_LDA(At, 1, 0); PG8_STAGE(PG8_SA(0, 1), a2 + hstepA, voffA);
            PG8_WAIT_L(8); PG8_BAR; PG8_WAIT_L(0); PG8_MMA(0, 0, At, B0); PG8_BAR; PG8_SCHED;
            PG8_LDB(B1, 1, 1); PG8_STAGE(PG8_SB(1, 0), b3, voffB);
            PG8_BAR; PG8_WAIT_L(0); PG8_MMA(0, 1, At, B1); PG8_BAR;
            PG8_LDA(At, 1, 1); PG8_STAGE(PG8_SA(1, 0), a3, voffA);
            PG8_BAR; PG8_WAIT_L(0); PG8_MMA(1, 0, At, B0); PG8_BAR; PG8_SCHED;
            PG8_STAGE(PG8_SB(1, 1), b3 + hstepB, voffB);
            PG8_WAIT_V(6); PG8_BAR; PG8_MMA(1, 1, At, B1); PG8_BAR;
        }
        PG8_STAMP();
        if constexpr (!Epi::AFTER_DRAIN) { E(acc, cur, wr, wc, fr, fq); S.done(cur); }
        PG8_STAMP();
        if (!has_next) break;
#pragma unroll
        for (int a = 0; a < 2; ++a)
#pragma unroll
            for (int b = 0; b < 2; ++b)
#pragma unroll
                for (int m = 0; m < 4; ++m)
#pragma unroll
                    for (int n = 0; n < 2; ++n) acc[a][b][m][n] = (f32x4){0.f, 0.f, 0.f, 0.f};
        cur = nxt; cA = nA; cB = nB; ++ui;
    }
    PG8_WAIT_V(0);
    if (wr == 0) PG8_BAR;
    PG8_BAR;
    if constexpr (Epi::AFTER_DRAIN) { E.fused(acc, cur, wr, wc, fr, fq, lds, wid, lane); S.done(cur); }
    PG8_STAMP();
    if (STAMP && wid == 0) { stamps[lane] = lane < nts ? (((unsigned long long)(unsigned)ts_hi << 32) | (unsigned)ts_lo) : 0ull;
        if (lane == 62) stamps[62] = rt_entry; if (lane == 63) stamps[63] = (unsigned long long)wall_clock64(); }
#undef PG8_STAMP
#undef PG8_SA
#undef PG8_SB
#undef PG8_STAGE
#undef PG8_LDA
#undef PG8_LDB
#undef PG8_MMA
#undef PG8_WAIT_V
#undef PG8_WAIT_L
#undef PG8_BAR
#undef PG8_SCHED
}
}

__device__ __forceinline__ void st8bf(u16* p, f32x4 a, f32x4 b) {
  u32x4 r = {pack2(a[0], a[1]), pack2(a[2], a[3]), pack2(b[0], b[1]), pack2(b[2], b[3])};
  *reinterpret_cast<u32x4*>(p) = r;
}
struct EpiY {
  static constexpr bool PERM = true, AFTER_DRAIN = false;
  u16* C; int ldc;
  __device__ __forceinline__ void operator()(const pg8::f32x4 (&acc)[2][2][4][2], const pg8::Unit& u, int wr, int wc, int fr, int fq) const {
    const int row0 = u.pm * 256 + wr * 64 + fr, col0 = u.pn * 256 + wc * 32 + 8 * fq;
#pragma unroll
    for (int ai = 0; ai < 2; ++ai)
#pragma unroll
      for (int m = 0; m < 4; ++m) {
        u16* rowp = C + (size_t)(row0 + ai * 128 + m * 16) * ldc + col0;
#pragma unroll
        for (int bj = 0; bj < 2; ++bj) st8bf(rowp + bj * 128, acc[ai][bj][m][0], acc[ai][bj][m][1]);
      }
  }
};
struct EpiSwiglu {
  static constexpr bool PERM = true, AFTER_DRAIN = false;
  u16* O;
  __device__ __forceinline__ void operator()(const pg8::f32x4 (&acc)[2][2][4][2], const pg8::Unit& u, int wr, int wc, int fr, int fq) const {
    const int row0 = u.pm * 256 + wr * 64 + fr, hb = u.pn * 128 + wc * 32 + 8 * fq;
#pragma unroll
    for (int ai = 0; ai < 2; ++ai)
#pragma unroll
      for (int m = 0; m < 4; ++m) {
        f32x4 v0, v1;
#pragma unroll
        for (int i = 0; i < 4; ++i) {
          v0[i] = silu_f(acc[ai][0][m][0][i]) * acc[ai][1][m][0][i];
          v1[i] = silu_f(acc[ai][0][m][1][i]) * acc[ai][1][m][1][i];
        }
        st8bf(O + (size_t)(row0 + ai * 128 + m * 16) * DFF + hb, v0, v1);
      }
  }
};
struct EpiQ {
  static constexpr bool PERM = true, AFTER_DRAIN = false;
  u16* O; float scale;
  __device__ __forceinline__ void operator()(const pg8::f32x4 (&acc)[2][2][4][2], const pg8::Unit& u, int wr, int wc, int fr, int fq) const {
    const int row0 = u.pm * 256 + wr * 64 + fr, col0 = u.pn * 256 + wc * 32 + 8 * fq;
#pragma unroll
    for (int ai = 0; ai < 2; ++ai)
#pragma unroll
      for (int m = 0; m < 4; ++m) {
        u16* rowp = O + (size_t)(row0 + ai * 128 + m * 16) * 1024 + col0;
#pragma unroll
        for (int bj = 0; bj < 2; ++bj) st8bf(rowp + bj * 128, acc[ai][bj][m][0] * scale, acc[ai][bj][m][1] * scale);
      }
  }
};
struct EpiWin {
  static constexpr bool PERM = true, AFTER_DRAIN = false;
  unsigned char* big;
  __device__ __forceinline__ void operator()(const pg8::f32x4 (&acc)[2][2][4][2], const pg8::Unit& u, int wr, int wc, int fr, int fq) const {
    const int row0 = u.pm * 256 + wr * 64 + fr;
    const int b = u.pm >> 6;
    const float s128 = 0.08838834764831845f;
#pragma unroll
    for (int bj = 0; bj < 2; ++bj) {
      const int cb = u.pn * 256 + bj * 128 + wc * 32;
      if (cb >= 3352) continue;
      u16* rmb = nullptr; int ld = 0; float rsc = 1.f; bool act = false;
      u16* trb = nullptr; int X = 0, sh = 6; bool dec = false; float lg = 0.f; int dcol = 0;
      if (cb < 512) { rmb = (u16*)(big + B_QN) + cb; ld = 512; rsc = 0.125f * 1.4426950408889634f; }
      else if (cb < 1280) {
        const int s = (cb - 512) >> 7, cc = (cb - 512) & 127, g = cc >> 6, d = cc & 63, bg = b * 2 + g;
        if (s == 3 || s == 5) { trb = (u16*)(big + (s == 3 ? B_VST : B_VWT)); X = bg * 256; sh = 6; dcol = d; }
        else { rmb = (u16*)(big + (s == 0 ? B_KCR : (s == 1 ? B_VCR : (s == 2 ? B_KS : B_KW)))) + (size_t)(b + g) * T * 64 + d; ld = 64; }
      } else if (cb < 3328) {
        const int cr = cb - 1280, wh = cr >> 9, cc = cr & 511, h = cc >> 7, d = cc & 127;
        if (wh == 0) { rmb = (u16*)(big + B_QR) + cc; ld = 512; }
        else if (wh == 1) { rmb = (u16*)(big + B_KR) + cc; ld = 512; rsc = s128;
                            trb = (u16*)(big + B_KRT); X = (b * 4 + h) * 128; sh = 7; dcol = d; dec = true; lg = ret_lg(h); }
        else if (wh == 2) { trb = (u16*)(big + B_VRT); X = (b * 4 + h) * 128; sh = 7; dcol = d; }
        else { rmb = (u16*)(big + B_GR) + cc; ld = 512; act = true; }
      }
      if (cb >= 3328) {
#pragma unroll
        for (int n = 0; n < 2; ++n) {
          const int gc = 8 * fq + 4 * n;
          if (gc < 24) {
#pragma unroll
            for (int ai = 0; ai < 2; ++ai)
#pragma unroll
              for (int m = 0; m < 4; ++m) {
                const int row = row0 + ai * 128 + m * 16;
                f32x4 v = acc[ai][bj][m][n], w4;
#pragma unroll
                for (int i = 0; i < 4; ++i) w4[i] = sigm_f(v[i]);
                *(f32x4*)((float*)(big + B_GS) + (size_t)row * 24 + gc) = w4;
              }
          }
        }
        continue;
      }
      if (rmb) {
#pragma unroll
        for (int ai = 0; ai < 2; ++ai)
#pragma unroll
          for (int m = 0; m < 4; ++m) {
            const int row = row0 + ai * 128 + m * 16;
            f32x4 v0 = acc[ai][bj][m][0] * rsc, v1 = acc[ai][bj][m][1] * rsc;
            if (act) {
#pragma unroll
              for (int i = 0; i < 4; ++i) { v0[i] = silu_f(v0[i]); v1[i] = silu_f(v1[i]); }
            }
            st8bf(rmb + (size_t)row * ld + 8 * fq, v0, v1);
          }
      }
      if (trb) {
        const int msk = (1 << sh) - 1;
#pragma unroll
        for (int n = 0; n < 2; ++n)
#pragma unroll
          for (int ai = 0; ai < 2; ++ai)
#pragma unroll
            for (int m = 0; m < 4; ++m) {
              const int t = (row0 + ai * 128 + m * 16) & 16383;
              u16* o = trb + ((size_t)(X + (t >> sh)) << (2 * sh)) + (t & msk) + ((size_t)(dcol + 8 * fq + 4 * n) << sh);
              const float sc = dec ? s128 * exp2f((float)(127 - (t & 127)) * lg) : 1.f;
              f32x4 v = acc[ai][bj][m][n] * sc;
              const u32 p01 = pack2(v[0], v[1]), p23 = pack2(v[2], v[3]);
              o[0] = (u16)p01;
              o[(size_t)1 << sh] = (u16)(p01 >> 16);
              o[(size_t)2 << sh] = (u16)p23;
              o[(size_t)3 << sh] = (u16)(p23 >> 16);
            }
      }
    }
  }
};
template <class Epi>
__device__ __forceinline__ void big_gemm(unsigned char* smem, const u16* A, const u16* Bt, int M, int N, int K, const Epi& E,
                                         int lda = 0, int boff = 0) {
  pg8::Gemm g{A, Bt, M, N, K, lda ? lda : K, K};
  pg8::StaticOrder S;
  const int G = gdim();
  S.init(M, N, G, (bidx() + G - boff) % G);
  pg8::gemm_phase<Epi, pg8::StaticOrder, false>((PG8_LAS unsigned char*)smem, g, S, E, nullptr);
}
struct EpiC1 {
  static constexpr bool PERM = false, AFTER_DRAIN = false;
  u16* O; const float* bias;
  __device__ __forceinline__ void operator()(const pg8::f32x4 (&acc)[2][2][4][2], const pg8::Unit& u, int wr, int wc, int fr, int fq) const {
    const int row0 = u.pm * 256 + wr * 64 + fr, col0 = wc * 32 + 4 * fq;
#pragma unroll
    for (int bj = 0; bj < 2; ++bj)
#pragma unroll
      for (int n = 0; n < 2; ++n) {
        const int col = col0 + bj * 128 + n * 16;
        f32x4 bv = {0.f, 0.f, 0.f, 0.f};
#pragma unroll 1
        for (int j = 0; j < 8; ++j) bv += *(const f32x4*)(bias + j * 256 + col);
#pragma unroll
        for (int ai = 0; ai < 2; ++ai)
#pragma unroll
          for (int m = 0; m < 4; ++m) {
            f32x4 v = acc[ai][bj][m][n] + bv, w;
#pragma unroll
            for (int i = 0; i < 4; ++i) w[i] = silu_f(v[i]);
            st4bf(O + (size_t)(row0 + ai * 128 + m * 16) * 256 + col, w);
          }
      }
  }
};

__device__ __forceinline__ void ld_kfp(const u16* __restrict__ kp, bf16x8 (&Kf)[2][2], int krow0, int fq) {
#pragma unroll
  for (int tl = 0; tl < 2; ++tl)
#pragma unroll
    for (int ks = 0; ks < 2; ++ks) Kf[tl][ks] = ld8(kp + (krow0 + tl * 4) * 64 + ks * 32 + fq * 8);
}
__device__ __forceinline__ void ld_vfp(const u16* __restrict__ vp, bf16x8 (&Vf)[4], int fr, int fq) {
#pragma unroll
  for (int dt = 0; dt < 4; ++dt) Vf[dt] = ld8(vp + ((dt >> 1) * 32 + (fr >> 2) * 8 + (dt & 1) * 4 + (fr & 3)) * 64 + fq * 8);
}
__device__ __forceinline__ void qk_r(const bf16x8 (&Kf)[2][2], const bf16x8 (&Qr)[2], f32x4& s0, f32x4& s1) {
  f32x4 z = {0.f, 0.f, 0.f, 0.f};
  s0 = mfma16(Kf[0][0], Qr[0], z);
  s0 = mfma16(Kf[0][1], Qr[1], s0);
  s1 = mfma16(Kf[1][0], Qr[0], z);
  s1 = mfma16(Kf[1][1], Qr[1], s1);
}
__device__ __forceinline__ void pv_tiles(const bf16x8 (&Vf)[4], const bf16x8 (&Pb)[4], f32x4 (&O)[4][4]) {
#pragma unroll
  for (int dt = 0; dt < 4; ++dt)
#pragma unroll
    for (int r = 0; r < 4; ++r) O[r][dt] = mfma16(Vf[dt], Pb[r], O[r][dt]);
}

template <int MODE, bool MASKED>
__device__ __forceinline__ void att_step(const bf16x8 (&Kc)[2][2], const bf16x8 (&Vc)[4], int d0, bool selq, const bf16x8* qlds,
                                         int lane, const float (&slope)[4], float (&m)[4], float (&ls)[4], f32x4 (&O)[4][4]) {
  float fd[2][4];
#pragma unroll
  for (int tl = 0; tl < 2; ++tl)
#pragma unroll
    for (int i = 0; i < 4; ++i) {
      const int dist = d0 - tl * 4 - i;
      bool v;
      if (MODE == 1) v = selq && (dist >= 0);
      else v = (dist >= 0) && (dist < 512);
      fd[tl][i] = (MASKED && !v) ? __builtin_inff() : (float)dist;
    }
  bf16x8 Pb[4];
#pragma unroll
  for (int r = 0; r < 4; ++r) {
    f32x4 sv[2];
    bf16x8 Qr[2];
    Qr[0] = qlds[(r * 2 + 0) * 64 + lane];
    Qr[1] = qlds[(r * 2 + 1) * 64 + lane];
    qk_r(Kc, Qr, sv[0], sv[1]);
    float mx = NEG;
#pragma unroll
    for (int tl = 0; tl < 2; ++tl)
#pragma unroll
      for (int i = 0; i < 4; ++i) {
        const float sc = __builtin_fmaf(-slope[r], fd[tl][i], sv[tl][i]);
        sv[tl][i] = sc;
        mx = fmaxf(mx, sc);
      }
    if (__any(mx > m[r] + 8.f)) {
      mx = fmaxf(mx, shx(mx, 16));
      mx = fmaxf(mx, shx(mx, 32));
      const float mn = fmaxf(m[r], mx);
      const float alpha = __builtin_amdgcn_exp2f(m[r] - mn);
      ls[r] *= alpha;
      m[r] = mn;
#pragma unroll
      for (int dt = 0; dt < 4; ++dt) O[r][dt] *= alpha;
    }
    float sum = 0.f;
#pragma unroll
    for (int tl = 0; tl < 2; ++tl)
#pragma unroll
      for (int i = 0; i < 4; ++i) {
        const float pv = __builtin_amdgcn_exp2f(sv[tl][i] - m[r]);
        sv[tl][i] = pv;
        sum += pv;
      }
    ls[r] += sum;
    Pb[r] = packp(sv[0], sv[1]);
  }
  pv_tiles(Vc, Pb, O);
}

template <int MODE>
__device__ __forceinline__ void att_one(int e, const bf16x8 (&Kc)[2][2], const bf16x8 (&Vc)[4], int t, u64 mymask, const bf16x8* qlds,
                                        int lane, int fr, int fq, const float (&slope)[4], float (&m)[4], float (&ls)[4],
                                        f32x4 (&O)[4][4]) {
  const int d0 = t - (e * 32 + fq * 8);
  bool selq = true;
  if (MODE == 1) {
    const int j = e >> 1;
    const int sb = (int)((mymask >> (j & 63)) & 1ull);
    selq = __shfl(sb, fr + 16 * (j >> 6), 64) != 0;
  }
  att_step<MODE, true>(Kc, Vc, d0, selq, qlds, lane, slope, m, ls, O);
}
template <int MODE>
__device__ __forceinline__ void att_loop(int ns, const u32* list, const u16* __restrict__ Kb, const u16* __restrict__ Vb, int t,
                                         int t0, u64 mymask, const bf16x8* qlds, int lane, int fr, int fq, const float (&slope)[4],
                                         float (&m)[4], float (&ls)[4], f32x4 (&O)[4][4]) {
  if (ns <= 0) return;
  const int krow0 = (fr >> 2) * 8 + (fr & 3);
  bf16x8 Ka[2][2];
  int ea = __builtin_amdgcn_readfirstlane((int)list[ns - 1]);
  ld_kfp(Kb + (size_t)ea * 2048, Ka, krow0, fq);
#pragma unroll 1
  for (int s = ns - 1; s >= 0; --s) {
    bf16x8 Va[4], Kq[2][2];
    ld_vfp(Vb + (size_t)(ea >> 1) * 4096 + (ea & 1) * 32, Va, fr, fq);
    int eb = ea;
    if (s >= 1) {
      eb = __builtin_amdgcn_readfirstlane((int)list[s - 1]);
      ld_kfp(Kb + (size_t)eb * 2048, Kq, krow0, fq);
    }
    att_one<MODE>(ea, Ka, Va, t, mymask, qlds, lane, fr, fq, slope, m, ls, O);
    if (s >= 1) {
#pragma unroll
      for (int tl = 0; tl < 2; ++tl)
#pragma unroll
        for (int ks = 0; ks < 2; ++ks) Ka[tl][ks] = Kq[tl][ks];
    }
    ea = eb;
  }
}

__device__ __forceinline__ void nsa_task(const P& p, int l, int b, int qt, int g, u32* keys, float* xch, int wid) {
  int lane = tidx() & 63, fr = lane & 15, fq = lane >> 4;
#define LAUNDER() asm volatile("" : "+v"(fr), "+v"(fq), "+v"(lane))
  const int t0 = qt * 16, t = t0 + fr, cur = t0 >> 6;
  const size_t tok = (size_t)b * T + t;
  unsigned char* big = p.ws + O_BIG;
  const u16* QN = (const u16*)(big + B_QN);
  const float* GS = (const float*)(big + B_GS);
  float* ONSA = (float*)(p.ws + O_Y);
  u16* CAT = (u16*)(p.ws + O_HB);
  u32* krow = keys + fr * KEYSTR;
  float ssq = 0.f;
  f32x4 O[4][4];
  {
    const int bg = b * 2 + g;
    bf16x8 Qf[4][2];
    float slope[4];
#pragma unroll
    for (int r = 0; r < 4; ++r) {
#pragma unroll
      for (int ks = 0; ks < 2; ++ks) Qf[r][ks] = ld8(QN + tok * 512 + (g * 4 + r) * 64 + ks * 32 + fq * 8);
      slope[r] = exp2f(-(float)(g * 4 + r + 1)) * 1.4426950408889634f;
    }
    const float* gsp = GS + tok * 24 + g * 12;
    float* onp = ONSA + tok * 512 + g * 256 + fq * 4;
    const u16* Kc = (const u16*)(p.ws + O_SMALL + S_KCC) + (size_t)bg * 65536;
    const u16* Vc = (const u16*)(p.ws + O_SMALL + S_VCT) + (size_t)bg * 65536;
    float m[4], ls[4];
    const int nlast = (t0 + 15 - 31) >> 4;
    const int nit = nlast >= 0 ? (nlast >> 5) + 1 : 0;
    LAUNDER();
#pragma unroll
    for (int r = 0; r < 4; ++r) { m[r] = NEG; ls[r] = 0.f; }
    {
      const int krow0 = (fr >> 2) * 8 + (fr & 3);
      bf16x8 Kf[2][2];
      if (nit > 0) ld_kfp(Kc, Kf, krow0, fq);
#pragma unroll 1
      for (int it = 0; it < nit; ++it) {
        bf16x8 Kn[2][2];
        const bool more = (it + 1 < nit);
        if (more) ld_kfp(Kc + (size_t)(it + 1) * 2048, Kn, krow0, fq);
        const int n0 = it * 32 + fq * 8;
        float fd[2][4];
#pragma unroll
        for (int tl = 0; tl < 2; ++tl)
#pragma unroll
          for (int i = 0; i < 4; ++i) {
            const int n = n0 + tl * 4 + i;
            fd[tl][i] = (16 * n + 31 <= t) ? (float)t - (16.f * (float)n + 15.5f) : __builtin_inff();
          }
#pragma unroll
        for (int r = 0; r < 4; ++r) {
          f32x4 sv[2];
          qk_r(Kf, Qf[r], sv[0], sv[1]);
          float mx = m[r];
#pragma unroll
          for (int tl = 0; tl < 2; ++tl)
#pragma unroll
            for (int i = 0; i < 4; ++i) {
              const float sc = __builtin_fmaf(-slope[r], fd[tl][i], sv[tl][i]);
              sv[tl][i] = sc;
              mx = fmaxf(mx, sc);
            }
          float sum = ls[r] * __builtin_amdgcn_exp2f(m[r] - mx);
#pragma unroll
          for (int tl = 0; tl < 2; ++tl)
#pragma unroll
            for (int i = 0; i < 4; ++i) sum += __builtin_amdgcn_exp2f(sv[tl][i] - mx);
          ls[r] = sum;
          m[r] = mx;
        }
        if (more) {
#pragma unroll
          for (int tl = 0; tl < 2; ++tl)
#pragma unroll
            for (int ks = 0; ks < 2; ++ks) Kf[tl][ks] = Kn[tl][ks];
        }
      }
    }
#pragma unroll
    for (int r = 0; r < 4; ++r) {
      float mr = fmaxf(m[r], shx(m[r], 16));
      mr = fmaxf(mr, shx(mr, 32));
      float lt = ls[r] * __builtin_amdgcn_exp2f(m[r] - mr);
      lt += shx(lt, 16);
      lt += shx(lt, 32);
      m[r] = mr + __builtin_amdgcn_logf(fmaxf(lt, 1e-30f));
    }
    LAUNDER();
#pragma unroll 1
    for (int i = 0; i < 16; ++i) {
      const u32 j = fq * 64 + i * 4;
      u32x4 kv = {255u - j, 254u - j, 253u - j, 252u - j};
      *reinterpret_cast<u32x4*>(krow + j) = kv;
    }
#pragma unroll
    for (int r = 0; r < 4; ++r)
#pragma unroll
      for (int dt = 0; dt < 4; ++dt) O[r][dt] = f32x4{0.f, 0.f, 0.f, 0.f};
    LAUNDER();
    {
      float carry = 0.f;
      const int krow0 = (fr >> 2) * 8 + (fr & 3);
      bf16x8 Kf[2][2];
      if (nit > 0) ld_kfp(Kc, Kf, krow0, fq);
#pragma unroll 1
      for (int it = 0; it < nit; ++it) {
        bf16x8 Vf[4], Kn[2][2];
        ld_vfp(Vc + (size_t)(it >> 1) * 4096 + (it & 1) * 32, Vf, fr, fq);
        const bool more = (it + 1 < nit);
        if (more) ld_kfp(Kc + (size_t)(it + 1) * 2048, Kn, krow0, fq);
        const int n0 = it * 32 + fq * 8;
        bf16x8 Pb[4];
        f32x4 ps[2] = {f32x4{0.f, 0.f, 0.f, 0.f}, f32x4{0.f, 0.f, 0.f, 0.f}};
        float fd[2][4];
#pragma unroll
        for (int tl = 0; tl < 2; ++tl)
#pragma unroll
          for (int i = 0; i < 4; ++i) {
            const int n = n0 + tl * 4 + i;
            fd[tl][i] = (16 * n + 31 <= t) ? (float)t - (16.f * (float)n + 15.5f) : __builtin_inff();
          }
#pragma unroll
        for (int r = 0; r < 4; ++r) {
          f32x4 sv[2];
          qk_r(Kf, Qf[r], sv[0], sv[1]);
#pragma unroll
          for (int tl = 0; tl < 2; ++tl) {
#pragma unroll
            for (int i = 0; i < 4; ++i)
              sv[tl][i] = __builtin_amdgcn_exp2f(__builtin_fmaf(-slope[r], fd[tl][i], sv[tl][i]) - m[r]);
            ps[tl] += sv[tl];
          }
          Pb[r] = packp(sv[0], sv[1]);
        }
        {
          const float c1 = 0.5f * ps[1][3];
          const float rcv = __shfl(c1, (lane + 48) & 63, 64);
          const float add = fq > 0 ? rcv : carry;
          carry = rcv;
          const float a0 = ps[0][0] + ps[0][1] + ps[0][2] + 0.5f * ps[0][3] + add;
          const float a1 = ps[1][0] + ps[1][1] + ps[1][2] + 0.5f * ps[1][3] + 0.5f * ps[0][3];
          const int j0 = it * 8 + fq * 2;
          u32x2 kk = {(__float_as_uint(a0) & 0xFFFFFF00u) | (u32)(255 - j0), (__float_as_uint(a1) & 0xFFFFFF00u) | (u32)(254 - j0)};
          *reinterpret_cast<u32x2*>(krow + j0) = kk;
        }
        pv_tiles(Vf, Pb, O);
        if (more) {
#pragma unroll
          for (int tl = 0; tl < 2; ++tl)
#pragma unroll
            for (int ks = 0; ks < 2; ++ks) Kf[tl][ks] = Kn[tl][ks];
        }
      }
    }
    LAUNDER();
    {
#pragma unroll
      for (int r = 0; r < 4; ++r) {
        const float gt = gsp[r * 3 + 0];
#pragma unroll
        for (int dt = 0; dt < 4; ++dt) *reinterpret_cast<f32x4*>(onp + r * 64 + dt * 16) = O[r][dt] * gt;
      }
    }
    LAUNDER();
    {
      const u32 F = 0x461C4000u;
      if (fq == 0) krow[0] = F | 255u;
      if (fq == (cur >> 6)) krow[cur] = F | (u32)(255 - cur);
      if (cur >= 1 && fq == ((cur - 1) >> 6)) krow[cur - 1] = F | (u32)(255 - (cur - 1));
    }
    __builtin_amdgcn_wave_barrier();
    u64 mymask = 0ull;
#pragma unroll 1
    for (int rd = 0; rd < 16; ++rd) {
      u32 mx = 0u;
      const u32x4* k4 = reinterpret_cast<const u32x4*>(krow + fq * 64);
#pragma unroll
      for (int i = 0; i < 16; ++i) {
        u32x4 v = k4[i];
        u32 a = v.x > v.y ? v.x : v.y;
        u32 c = v.z > v.w ? v.z : v.w;
        a = a > c ? a : c;
        mx = mx > a ? mx : a;
      }
      u32 o1 = (u32)__shfl_xor((int)mx, 16, 64);
      mx = mx > o1 ? mx : o1;
      u32 o2 = (u32)__shfl_xor((int)mx, 32, 64);
      mx = mx > o2 ? mx : o2;
      const int jw = 255 - (int)(mx & 255u);
      if ((jw >> 6) == fq) {
        krow[jw] = 0u;
        mymask |= 1ull << (jw & 63);
      }
      __builtin_amdgcn_wave_barrier();
    }
    u32 ulo = (u32)mymask, uhi = (u32)(mymask >> 32);
#pragma unroll
    for (int o = 1; o <= 8; o <<= 1) {
      ulo |= (u32)__shfl_xor((int)ulo, o, 64);
      uhi |= (u32)__shfl_xor((int)uhi, o, 64);
    }
    bf16x8* qlds = reinterpret_cast<bf16x8*>(keys);
    u32* list = keys + 2048;
    __builtin_amdgcn_wave_barrier();
#pragma unroll
    for (int r = 0; r < 4; ++r)
#pragma unroll
      for (int ks = 0; ks < 2; ++ks) qlds[(r * 2 + ks) * 64 + lane] = Qf[r][ks];
    int ns = 0;
    const int nhc = ((t0 + 15 - 64 * cur) >> 5) + 1;
#pragma unroll 1
    for (int part = 0; part < 4; ++part) {
      u64 um = ((u64)(u32)__builtin_amdgcn_readlane((int)uhi, part * 16) << 32) |
               (u64)(u32)__builtin_amdgcn_readlane((int)ulo, part * 16);
      while (um) {
        const int bit = __builtin_ctzll(um);
        um &= um - 1;
        const int j = part * 64 + bit;
        if (j > cur) break;
        const int nh = (j == cur) ? nhc : 2;
        if (lane == 0) { list[ns] = (u32)(2 * j); if (nh > 1) list[ns + 1] = (u32)(2 * j + 1); }
        ns += nh;
      }
    }
    __builtin_amdgcn_wave_barrier();
    LAUNDER();
    const u16* KS = (const u16*)(big + B_KS) + (size_t)bg * T * 64;
    const u16* VST = (const u16*)(big + B_VST) + (size_t)bg * 256 * 4096;
#pragma unroll
    for (int r = 0; r < 4; ++r) {
      m[r] = NEG; ls[r] = 0.f;
#pragma unroll
      for (int dt = 0; dt < 4; ++dt) O[r][dt] = f32x4{0.f, 0.f, 0.f, 0.f};
    }
    att_loop<1>(ns, list, KS, VST, t, t0, mymask, qlds, lane, fr, fq, slope, m, ls, O);
    LAUNDER();
#pragma unroll
    for (int r = 0; r < 4; ++r) {
      float lt = ls[r] + shx(ls[r], 16);
      lt += shx(lt, 32);
      const float sc = gsp[r * 3 + 1] / fmaxf(lt, 1e-30f);
#pragma unroll
      for (int dt = 0; dt < 4; ++dt) {
        f32x4* ptr = reinterpret_cast<f32x4*>(onp + r * 64 + dt * 16);
        *ptr = *ptr + O[r][dt] * sc;
      }
    }
    LAUNDER();
    const u16* KW = (const u16*)(big + B_KW) + (size_t)bg * T * 64;
    const u16* VWT = (const u16*)(big + B_VWT) + (size_t)bg * 256 * 4096;
#pragma unroll
    for (int r = 0; r < 4; ++r) {
      m[r] = NEG; ls[r] = 0.f;
#pragma unroll
      for (int dt = 0; dt < 4; ++dt) O[r][dt] = f32x4{0.f, 0.f, 0.f, 0.f};
    }
    {
      const int lo = t0 - 511 > 0 ? t0 - 511 : 0;
      const int e0 = (lo >> 6) * 2;
      const int nsw = cur * 2 + nhc - e0;
      __builtin_amdgcn_wave_barrier();
#pragma unroll 1
      for (int i = lane; i < nsw; i += 64) list[i] = (u32)(e0 + i);
      __builtin_amdgcn_wave_barrier();
      att_loop<2>(nsw, list, KW, VWT, t, t0, 0ull, qlds, lane, fr, fq, slope, m, ls, O);
    }
    LAUNDER();
#pragma unroll
    for (int r = 0; r < 4; ++r) {
      float lt = ls[r] + shx(ls[r], 16);
      lt += shx(lt, 32);
      const float sc = gsp[r * 3 + 2] / fmaxf(lt, 1e-30f);
#pragma unroll
      for (int dt = 0; dt < 4; ++dt) {
        f32x4* ptr = reinterpret_cast<f32x4*>(onp + r * 64 + dt * 16);
        f32x4 v = *ptr + O[r][dt] * sc;
        ssq += v[0] * v[0] + v[1] * v[1] + v[2] * v[2] + v[3] * v[3];
        O[r][dt] = v;
      }
    }
  }
  LAUNDER();
  ssq += shx(ssq, 16);
  ssq += shx(ssq, 32);
  if (fq == 0) xch[wid * 16 + fr] = ssq;
  __syncthreads();
  const float tot = ssq + xch[(wid ^ 1) * 16 + fr];
  const float rinv = rsqrtf(tot * (1.f / 512.f) + EPS);
  const float* gn = p.nsa_out_g + (size_t)l * 512 + g * 256 + fq * 8;
  u16* cp = CAT + tok * 1024 + g * 256 + fq * 8;
#pragma unroll
  for (int r = 0; r < 4; ++r)
#pragma unroll
    for (int pp = 0; pp < 2; ++pp) {
      f32x4 g0 = *reinterpret_cast<const f32x4*>(gn + r * 64 + pp * 32), g1 = *reinterpret_cast<const f32x4*>(gn + r * 64 + pp * 32 + 4);
      st8bf_n(cp + r * 64 + pp * 32, O[r][2 * pp] * g0 * rinv, O[r][2 * pp + 1] * g1 * rinv);
    }
}
#undef LAUNDER
__device__ __forceinline__ void ret_kv_block(const P& p, int first, int step, unsigned char* smem) {
  const int tid = tidx(), lane = tid & 63, wid = __builtin_amdgcn_readfirstlane(tid >> 6), fr = lane & 15, fq = lane >> 4;
  u32x4 rg[8];
  auto gload = [&](int ch) {
    const u16* Kt = (const u16*)(p.ws + O_BIG + B_KRT) + (size_t)ch * 16384;
    const u16* Vt = (const u16*)(p.ws + O_BIG + B_VRT) + (size_t)ch * 16384;
#pragma unroll
    for (int i = 0; i < 8; ++i) {
      const int slot = wid * 8 + i;
      const u16* src = (slot < 32 ? Kt : Vt) + (((slot & 31) >> 2) * 16 + fr) * 128 + (slot & 3) * 32 + fq * 8;
      rg[i] = *reinterpret_cast<const u32x4*>(src);
    }
  };
  if (first < 1024) gload(first);
  for (int ch = first; ch < 1024; ch += step) {
    __syncthreads();
#pragma unroll
    for (int i = 0; i < 8; ++i) *reinterpret_cast<u32x4*>(smem + (wid * 8 + i) * 1024 + lane * 16) = rg[i];
    __syncthreads();
    if (ch + step < 1024) gload(ch + step);
    float* KVF = (float*)(p.ws + O_Y) + (size_t)ch * 16384;
    const unsigned char* lb = smem + lane * 16;
    bf16x8 Af[4];
#pragma unroll
    for (int ks = 0; ks < 4; ++ks) Af[ks] = *reinterpret_cast<const bf16x8*>(lb + (wid * 4 + ks) * 1024);
#pragma unroll
    for (int et = 0; et < 8; ++et) {
      f32x4 acc = {0.f, 0.f, 0.f, 0.f};
#pragma unroll
      for (int ks = 0; ks < 4; ++ks) acc = mfma16(Af[ks], *reinterpret_cast<const bf16x8*>(lb + (32 + et * 4 + ks) * 1024), acc);
      *reinterpret_cast<f32x4*>(KVF + (et * 16 + fr) * 128 + wid * 16 + fq * 4) = acc;
    }
  }
}
__device__ __forceinline__ void ret_scan(const P& p) {
  const float* KVF = (const float*)(p.ws + O_Y);
  u16* ST = (u16*)(p.ws + O_Y + 64 * MiB);
  const int gt = bidx() * 512 + tidx(), nt = gdim() * 512;
  for (int idx = gt; idx < 8 * 4096; idx += nt) {
    const int bh = idx >> 12, ed = (idx & 4095) * 4, h = bh & 3;
    const float cd = exp2f(128.f * ret_lg(h));
    f32x4 st = {0.f, 0.f, 0.f, 0.f};
    const size_t base = (size_t)bh * 128 * 16384 + ed;
#pragma unroll 4
    for (int c = 0; c < 128; ++c) {
      st4bf(ST + base + (size_t)c * 16384, st);
      st = st * cd + *reinterpret_cast<const f32x4*>(KVF + base + (size_t)c * 16384);
    }
  }
}
__device__ __forceinline__ void ret_out_block(const P& p, int l, int first, int step, unsigned char* smem) {
  const int tid = tidx(), lane = tid & 63, wid = __builtin_amdgcn_readfirstlane(tid >> 6), fr = lane & 15, fq = lane >> 4;
  unsigned char* big = p.ws + O_BIG;
  const u16* QR = (const u16*)(big + B_QR);
  const u16* KR = (const u16*)(big + B_KR);
  const u16* GR = (const u16*)(big + B_GR);
  u16* CAT = (u16*)(p.ws + O_HB);
  const int krow0 = (fr >> 2) * 8 + (fr & 3);
  u32x4 rg[12];
  auto gload = [&](int ch) {
    const int c = ch & 127, bh = ch >> 7, h = bh & 3, b = bh >> 2;
    const size_t tokc = (size_t)b * T + (size_t)c * 128;
    const u16* Vt = (const u16*)(big + B_VRT) + (size_t)ch * 16384;
    const u16* ST = (const u16*)(p.ws + O_Y + 64 * MiB) + (size_t)ch * 16384;
#pragma unroll
    for (int i = 0; i < 12; ++i) {
      const int slot = wid * 12 + i;
      const u16* src;
      if (slot < 32) {
        const int u = slot >> 3, tl = (slot >> 2) & 1, ks = slot & 3;
        src = KR + (tokc + u * 32 + krow0 + tl * 4) * 512 + h * 128 + ks * 32 + fq * 8;
      } else if (slot < 64) {
        const int et = (slot - 32) >> 2, u = slot & 3;
        src = Vt + ((et >> 1) * 32 + (fr >> 2) * 8 + (et & 1) * 4 + (fr & 3)) * 128 + u * 32 + fq * 8;
      } else {
        const int et = (slot - 64) >> 2, ks = slot & 3;
        src = ST + ((et >> 1) * 32 + (fr >> 2) * 8 + (et & 1) * 4 + (fr & 3)) * 128 + ks * 32 + fq * 8;
      }
      rg[i] = *reinterpret_cast<const u32x4*>(src);
    }
  };
  if (first < 1024) gload(first);
  for (int ch = first; ch < 1024; ch += step) {
    const int c = ch & 127, bh = ch >> 7, h = bh & 3, b = bh >> 2;
    __syncthreads();
#pragma unroll
    for (int i = 0; i < 12; ++i) *reinterpret_cast<u32x4*>(smem + (wid * 12 + i) * 1024 + lane * 16) = rg[i];
    __syncthreads();
    if (ch + step < 1024) gload(ch + step);
    const size_t tokc = (size_t)b * T + (size_t)c * 128;
    const int n = wid * 16 + fr;
    const size_t tok = tokc + n;
    const float lg = ret_lg(h);
    bf16x8 Qf[4];
#pragma unroll
    for (int ks = 0; ks < 4; ++ks) Qf[ks] = ld8(QR + tok * 512 + h * 128 + ks * 32 + fq * 8);
    f32x4 O[8];
#pragma unroll
    for (int et = 0; et < 8; ++et) O[et] = f32x4{0.f, 0.f, 0.f, 0.f};
    const unsigned char* lb = smem + lane * 16;
    const int nu = (wid >> 1) + 1;
#pragma unroll 1
    for (int u = 0; u < nu; ++u) {
      f32x4 S[2];
#pragma unroll
      for (int tl = 0; tl < 2; ++tl) {
        f32x4 z = {0.f, 0.f, 0.f, 0.f};
#pragma unroll
        for (int ks = 0; ks < 4; ++ks) z = mfma16(*reinterpret_cast<const bf16x8*>(lb + (u * 8 + tl * 4 + ks) * 1024), Qf[ks], z);
#pragma unroll
        for (int i = 0; i < 4; ++i) {
          const int diff = n - (u * 32 + fq * 8 + tl * 4 + i);
          z[i] = diff >= 0 ? z[i] * __builtin_amdgcn_exp2f((float)diff * lg) : 0.f;
        }
        S[tl] = z;
      }
      bf16x8 Pb = packp(S[0], S[1]);
#pragma unroll
      for (int et = 0; et < 8; ++et) O[et] = mfma16(*reinterpret_cast<const bf16x8*>(lb + (32 + et * 4 + u) * 1024), Pb, O[et]);
    }
    const float qd = __builtin_amdgcn_exp2f((float)(n + 1) * lg);
    float s1 = 0.f;
#pragma unroll
    for (int et = 0; et < 8; ++et) {
      f32x4 x = {0.f, 0.f, 0.f, 0.f};
#pragma unroll
      for (int ks = 0; ks < 4; ++ks) x = mfma16(*reinterpret_cast<const bf16x8*>(lb + (64 + et * 4 + ks) * 1024), Qf[ks], x);
      O[et] += x * qd;
      s1 += O[et][0] + O[et][1] + O[et][2] + O[et][3];
    }
    s1 += shx(s1, 16);
    s1 += shx(s1, 32);
    const float mu = s1 * (1.f / 128.f);
    float s2 = 0.f;
#pragma unroll
    for (int et = 0; et < 8; ++et) {
      O[et] -= mu;
      s2 += O[et][0] * O[et][0] + O[et][1] * O[et][1] + O[et][2] * O[et][2] + O[et][3] * O[et][3];
    }
    s2 += shx(s2, 16);
    s2 += shx(s2, 32);
    const float rinv = rsqrtf(s2 * (1.f / 128.f) + EPS);
    const float* gn = p.ret_gn_g + (size_t)l * 512 + h * 128;
#pragma unroll
    for (int pp = 0; pp < 4; ++pp) {
      const int e = pp * 32 + fq * 8;
      f32x4 g0 = *reinterpret_cast<const f32x4*>(gn + e), g1 = *reinterpret_cast<const f32x4*>(gn + e + 4);
      u32x4 gr = *reinterpret_cast<const u32x4*>(GR + tok * 512 + h * 128 + e);
      f32x4 sg0, sg1;
      bf8_to_f32(gr, sg0, sg1);
      st8bf_n(CAT + tok * 1024 + 512 + h * 128 + e, O[2 * pp] * rinv * g0 * sg0, O[2 * pp + 1] * rinv * g1 * sg1);
    }
  }
}

__device__ __forceinline__ void xattn_block(const P& p, int id, unsigned char* smem) {
  const int tid = tidx(), lane = tid & 63, wid = __builtin_amdgcn_readfirstlane(tid >> 6), fr = lane & 15, fq = lane >> 4;
  const int qb = id & 127, hd = (id >> 7) & 3, b = id >> 9;
  const u16* QX = (const u16*)(p.ws + O_BIG);
  u16* OX = (u16*)(p.ws + O_BIG + 64 * MiB);
  const u16* KM = (const u16*)(p.ws + O_SMALL + S_KMEM) + (size_t)b * 256 * 1024 + hd * 256;
  const u16* VM = (const u16*)(p.ws + O_SMALL + S_VMEMT) + ((size_t)b * 1024 + hd * 256) * 256;
  const size_t tok = (size_t)b * T + qb * 128 + wid * 16 + fr;
  bf16x8 Qf[8];
#pragma unroll
  for (int ks = 0; ks < 8; ++ks) Qf[ks] = ld8(QX + tok * 1024 + hd * 256 + ks * 32 + fq * 8);
  f32x4 O[16];
#pragma unroll
  for (int et = 0; et < 16; ++et) O[et] = f32x4{0.f, 0.f, 0.f, 0.f};
  float m = NEG, ls = 0.f;
  const int krow0 = (fr >> 2) * 8 + (fr & 3);
  u32x4 rk[2], rv[2];
  auto gload = [&](int c) {
#pragma unroll
    for (int i = 0; i < 2; ++i) {
      const int slot = wid * 2 + i, tl = slot >> 3, ks = slot & 7;
      rk[i] = *reinterpret_cast<const u32x4*>(KM + (size_t)(c * 32 + krow0 + tl * 4) * 1024 + ks * 32 + fq * 8);
      rv[i] = *reinterpret_cast<const u32x4*>(VM + (size_t)((slot >> 1) * 32 + (fr >> 2) * 8 + (slot & 1) * 4 + (fr & 3)) * 256 + c * 32 + fq * 8);
    }
  };
  auto swrite = [&](int buf) {
#pragma unroll
    for (int i = 0; i < 2; ++i) {
      const int slot = wid * 2 + i;
      *reinterpret_cast<u32x4*>(smem + buf * 32768 + slot * 1024 + lane * 16) = rk[i];
      *reinterpret_cast<u32x4*>(smem + buf * 32768 + 16384 + slot * 1024 + lane * 16) = rv[i];
    }
  };
  __syncthreads();
  gload(0);
  swrite(0);
  __syncthreads();
#pragma unroll 1
  for (int c = 0; c < 8; ++c) {
    const int buf = c & 1;
    if (c + 1 < 8) gload(c + 1);
    const unsigned char* kb = smem + buf * 32768 + lane * 16;
    const unsigned char* vb = kb + 16384;
    f32x4 S[2];
#pragma unroll
    for (int tl = 0; tl < 2; ++tl) {
      f32x4 z = {0.f, 0.f, 0.f, 0.f};
#pragma unroll
      for (int ks = 0; ks < 8; ++ks) z = mfma16(*reinterpret_cast<const bf16x8*>(kb + (tl * 8 + ks) * 1024), Qf[ks], z);
      S[tl] = z;
    }
    float mx = fmaxf(fmaxf(fmaxf(S[0][0], S[0][1]), fmaxf(S[0][2], S[0][3])), fmaxf(fmaxf(S[1][0], S[1][1]), fmaxf(S[1][2], S[1][3])));
    mx = fmaxf(mx, shx(mx, 16));
    mx = fmaxf(mx, shx(mx, 32));
    const float mn = fmaxf(m, mx);
    const float alpha = __expf(m - mn);
    float sum = 0.f;
#pragma unroll
    for (int tl = 0; tl < 2; ++tl)
#pragma unroll
      for (int i = 0; i < 4; ++i) {
        float e = __expf(S[tl][i] - mn);
        S[tl][i] = e;
        sum += e;
      }
    ls = ls * alpha + sum;
    m = mn;
    bf16x8 Pb = packp(S[0], S[1]);
#pragma unroll
    for (int et = 0; et < 16; ++et) {
      O[et] *= alpha;
      O[et] = mfma16(*reinterpret_cast<const bf16x8*>(vb + et * 1024), Pb, O[et]);
    }
    if (c + 1 < 8) swrite(buf ^ 1);
    __syncthreads();
  }
  ls += shx(ls, 16);
  ls += shx(ls, 32);
  const float inv = 1.f / ls;
#pragma unroll
  for (int pp = 0; pp < 8; ++pp) st8bf_n(OX + tok * 1024 + hd * 256 + pp * 32 + fq * 8, O[2 * pp] * inv, O[2 * pp + 1] * inv);
}

#define XB_TMO      128
#define XB_XCNT(j)  (256  + 64 * (j))
#define XB_XSUB(j)  (1280 + 64 * (j))
#define XB_XGEN(j)  (2304 + 64 * (j))
#define XB_TOP      3328
#define XB_TOPGEN   3392
#define XCD_BAR_WORDS 3456
#define XB_SPIN_CAP (1u << 18)
#define LAS __attribute__((address_space(3)))

__device__ __forceinline__ unsigned xb_ld(unsigned* p)              { return __hip_atomic_load(p, __ATOMIC_RELAXED, __HIP_MEMORY_SCOPE_AGENT); }
__device__ __forceinline__ unsigned xb_add(unsigned* p, unsigned v) { return __hip_atomic_fetch_add(p, v, __ATOMIC_RELAXED, __HIP_MEMORY_SCOPE_AGENT); }
__device__ __forceinline__ unsigned xb_xcc_id() { return (unsigned)__builtin_amdgcn_s_getreg((3 << 11) | 20) & 0xFu; }
#define XB_SPIN(cond, bar) do { unsigned _sp = 0; while (cond) { __builtin_amdgcn_s_sleep(1); \
    if ((++_sp & 255u) == 0u) { if (xb_ld(&(bar)[XB_TMO])) break; if (_sp > XB_SPIN_CAP) { atomicAdd(&(bar)[XB_TMO], 1u); break; } } } } while (0)

struct XcdBarrier {
    unsigned* bar; unsigned x;
    volatile LAS unsigned* st;
};

__device__ __forceinline__ XcdBarrier xcd_barrier_post(unsigned* bar, volatile LAS unsigned* st) {
    XcdBarrier b; b.bar = bar; b.x = xb_xcc_id(); b.st = st;
    if (threadIdx.x == 0) (void)xb_add(&bar[XB_XCNT(b.x)], 1u);
    return b;
}
__device__ __forceinline__ void xcd_barrier_complete(unsigned* bar, unsigned x, unsigned& nloc, unsigned& nx) {
    const unsigned G = gridDim.x * gridDim.y * gridDim.z;
    unsigned sum, cnt, mine, sp = 0u;
    for (;;) {
        sum = 0u; cnt = 0u; mine = 0u;
#pragma unroll
        for (unsigned j = 0; j < 16; ++j) { const unsigned c = xb_ld(&bar[XB_XCNT(j)]); sum += c; cnt += (c > 0u) ? 1u : 0u; mine = (j == x) ? c : mine; }
        if (sum == G) break;
        __builtin_amdgcn_s_sleep(1);
        if ((++sp & 255u) == 0u) { if (xb_ld(&bar[XB_TMO])) break; if (sp > XB_SPIN_CAP) { atomicAdd(&bar[XB_TMO], 1u); break; } }
    }
    nloc = mine > 0u ? mine : 1u; nx = cnt > 0u ? cnt : 1u;
}

__device__ __forceinline__ void xcd_barrier(const XcdBarrier& b) {
    asm volatile("s_waitcnt vmcnt(0)" ::: "memory");
    __syncthreads();
    if (threadIdx.x == 0) {
        unsigned* bar = b.bar;
        __builtin_amdgcn_s_waitcnt(0);
        unsigned nloc = b.st[0], nx = b.st[1];
        if (nloc == 0u) { xcd_barrier_complete(bar, b.x, nloc, nx); b.st[0] = nloc; b.st[1] = nx; }
        const unsigned old = xb_add(&bar[XB_XSUB(b.x)], 1u);
        const unsigned gen = old / nloc;
        if (old + 1u == (gen + 1u) * nloc) {
            __builtin_amdgcn_fence(__ATOMIC_RELEASE, "agent");
            asm volatile("s_waitcnt vmcnt(0)" ::: "memory");
            const unsigned og = xb_add(&bar[XB_TOP], 1u);
            const unsigned tg = og / nx;
            if (og + 1u == (tg + 1u) * nx) xb_add(&bar[XB_TOPGEN], 1u);
            else XB_SPIN(xb_ld(&bar[XB_TOPGEN]) == tg, bar);
            __builtin_amdgcn_fence(__ATOMIC_ACQUIRE, "agent");
            xb_add(&bar[XB_XGEN(b.x)], 1u);
            asm volatile("s_waitcnt vmcnt(0)" ::: "memory");
        } else {
            XB_SPIN(xb_ld(&bar[XB_XGEN(b.x)]) == gen, bar);
            __builtin_amdgcn_fence(__ATOMIC_ACQUIRE, "agent");
            asm volatile("s_waitcnt vmcnt(0)" ::: "memory");
        }
    }
    __syncthreads();
}

__device__ __forceinline__ void run_phase(const P& p, int ph, unsigned char* smem) {
  unsigned char* ws = p.ws;
  u16* sm = reinterpret_cast<u16*>(smem);
  u16* HB = (u16*)(ws + O_HB);
  float* Y = (float*)(ws + O_Y);
  unsigned char* big = ws + O_BIG;
  u16* ACT = (u16*)big;
  const int wid = __builtin_amdgcn_readfirstlane(tidx() >> 6);
  const int gw = bidx() * 8 + wid, nw = gdim() * 8;
  const int l = ph == 0 ? 0 : (ph - 1) >> 4;
  const int sub = ph == 0 ? -1 : (ph - 1) & 15;
  const u16* memn = (const u16*)(ws + O_SMALL + S_MEMN) + (size_t)l * 512 * 1024;

  {
    u16* XB = (u16*)((unsigned char*)p.out + 64 * MiB);
    int njobs = 0;
    if (ph == 0) njobs = 3;
    else if (sub == 2 || sub == 8 || sub == 12 || sub == 15) njobs = 1;
    for (int jb = 0; jb < njobs; ++jb) {
      const float *xin_f = nullptr, *gpost = nullptr, *gpre = nullptr;
      const u16 *xin_b = XB, *y = (const u16*)Y;
      u16 *xout_b = XB, *hb = HB;
      float *xout_f = nullptr, *xout_f2 = nullptr;
      float w = 1.f;
      int ntok = NTOK;
      if (ph == 0) {
        if (jb == 0) { xin_f = p.x; xin_b = nullptr; y = nullptr; gpre = p.ffn1_pre_g; }
        else {
          xin_f = p.mem; xin_b = nullptr; y = nullptr; xout_b = nullptr; gpre = p.xa_mem_g + (jb - 1) * 1024;
          hb = (u16*)(ws + O_SMALL + S_MEMN) + (size_t)(jb - 1) * 512 * 1024; ntok = 512;
        }
      } else if (sub == 2) { gpost = p.ffn1_post_g + l * 1024; w = 0.5f; gpre = p.mix_pre_g + l * 1024; }
      else if (sub == 8) { gpost = p.mix_post_g + l * 1024; gpre = p.xa_pre_g + l * 1024; }
      else if (sub == 12) { gpost = p.xa_post_g + l * 1024; gpre = p.ffn2_pre_g + l * 1024; if (l == 1) xout_b = (u16*)(big + 176 * MiB); }
      else {
        gpost = p.ffn2_post_g + l * 1024; w = 0.5f;
        if (l == 0) gpre = p.ffn1_pre_g + 1024;
        else {
          gpre = nullptr; hb = nullptr; xout_b = nullptr; xin_b = (const u16*)(big + 176 * MiB); xout_f = p.out; xout_f2 = p.out;
        }
      }
      norm_phase(xin_f, xin_b, y, gpost, w, xout_b, xout_f, xout_f2, gpre, hb, ntok);
    }
  }
  if (ph == 0 || (sub == 15 && l == 0)) convert_layer(p, ph == 0 ? 0 : 1, smem);
  if (sub == 0 || sub == 13) {
    EpiSwiglu E{ACT};
    big_gemm(smem, HB, (const u16*)(ws + (sub == 0 ? W_GU1 : W_GU2)), NTOK, 5632, 1024, E);
  }
  if (sub == 1 || sub == 7 || sub == 11 || sub == 14) {
    const u16* A = ACT; const u16* Bt = (u16*)(ws + W_D1); int K = DFF;
    if (sub == 7) { A = HB; Bt = (u16*)(ws + W_OUT); K = 1024; }
    else if (sub == 11) { A = (const u16*)(big + 64 * MiB); Bt = (u16*)(ws + W_O); K = 1024; }
    else if (sub == 14) { Bt = (u16*)(ws + W_D2); }
    EpiY E{(u16*)Y, 1024};
    big_gemm(smem, A, Bt, NTOK, 1024, K, E);
  }
  if (sub == 9) {
    EpiQ E{(u16*)big, 0.0625f};
    big_gemm(smem, HB, (const u16*)(ws + W_Q), NTOK, 1024, 1024, E);
  }
  if (sub == 3) {
    EpiWin E{big};
    big_gemm(smem, HB, (const u16*)(ws + W_IN), NTOK, 3584, 1024, E);
  }
  if (sub == 4) {
#pragma unroll 1
    for (int kv = 0; kv < 2; ++kv) {
      EpiC1 E{(u16*)(ws + O_SMALL + S_HC) + (size_t)kv * 4096 * 256, reinterpret_cast<const float*>(ws + W_BIAS) + kv * 8 * 256};
      big_gemm(smem, (const u16*)(big + (kv == 0 ? B_KCR : B_VCR)), (const u16*)(ws + W_C1) + (size_t)kv * 256 * 2048, 4096, 256, 2048,
               E, 1024, kv * 16);
    }
    gemm_phase<EP_BF16>(p, 0, 1.f, ws + O_SMALL + S_KMEM, 1024, memn, 1024, (u16*)(ws + W_K), 1024, 512, 1024, 1024, sm, 64);
    gemm_phase<EP_VMEMT>(p, 0, 1.f, ws + O_SMALL + S_VMEMT, 0, memn, 1024, (u16*)(ws + W_V), 1024, 512, 1024, 1024, sm, 96);
    ret_kv_block(p, bidx(), gdim(), smem);
  }
  if (sub == 5) {
    gemm_phase<EP_C2K>(p, 0, 1.f, ws + O_SMALL + S_KCC, 64, (const u16*)(ws + O_SMALL + S_HC), 256, (u16*)(ws + W_C2), 256,
                       4096, 128, 256, sm, 0);
    gemm_phase<EP_C2V>(p, 0, 1.f, ws + O_SMALL + S_VCT, 64, (const u16*)(ws + O_SMALL + S_HC) + (size_t)4096 * 256, 256,
                       (u16*)(ws + W_C2) + 128 * 256, 256, 4096, 128, 256, sm, 128);
    ret_scan(p);
  }
  if (sub == 6) {
    u32* keys = reinterpret_cast<u32*>(smem) + wid * 16 * KEYSTR;
    const int slots = gdim() * 4;
    for (int i = 0; i * slots < 2048; ++i) {
      const int u = i * slots + bidx() * 4 + (wid >> 1);
      float* xch = reinterpret_cast<float*>(smem + SMEM_BYTES + 64) + (i & 1) * 128;
      if (u < 2048) {
        const int qt = u < 1024 ? 1023 - (u >> 1) : (u - 1024) >> 1;
        nsa_task(p, l, u & 1, qt, (wid & 1) ^ (i & 1), keys, xch, wid);
      } else {
        __syncthreads();
      }
    }
    ret_out_block(p, l, bidx(), gdim(), smem);
  }
  if (sub == 10)
    for (int id = bidx(); id < 1024; id += gdim()) xattn_block(p, id, smem);
}

__global__ void __launch_bounds__(512) hymba_mega(P p, int ph0, int ph1) {
  extern __shared__ __attribute__((aligned(16))) unsigned char smem[];
  cg::grid_group grid = cg::this_grid();
  volatile LAS unsigned* st = (volatile LAS unsigned*)(smem + SMEM_BYTES);
  if (threadIdx.x < 4) st[threadIdx.x] = 0u;
  __syncthreads();
  XcdBarrier xb = xcd_barrier_post((unsigned*)(p.ws + O_SMALL + S_BAR), st);
  for (int ph = ph0; ph < ph1; ++ph) {
#if defined(__HIP_DEVICE_COMPILE__)
    const __attribute__((address_space(4))) P* pp =
        (const __attribute__((address_space(4))) P*)__builtin_amdgcn_kernarg_segment_ptr();
    asm volatile("" : "+s"(pp));
    P q = *pp;
    run_phase(q, ph, smem);
#endif
    if (ph + 1 < ph1) {
      if (ph1 < 0) grid.sync();
      xcd_barrier(xb);
    }
  }
}

extern "C" void kernel_launch(void* const* d_in, const int* in_sizes, int n_in, void* d_out, int out_size, void* d_ws,
                              size_t ws_size, hipStream_t stream) {
  P p{};
  const float** pp = reinterpret_cast<const float**>(&p);
  for (int i = 0; i < 28; ++i) pp[i] = (const float*)d_in[i];
  p.out = (float*)d_out;
  p.ws = (unsigned char*)d_ws;
  if (ws_size < WS_NEED) {
    fprintf(stderr, "workspace too small: %zu < %zu\n", ws_size, (size_t)WS_NEED);
    return;
  }
  static int grid_blocks = 0;
  if (!grid_blocks) {
    hipFuncSetAttribute((const void*)hymba_mega, hipFuncAttributeMaxDynamicSharedMemorySize, SMEM_BYTES + 64 + 1024);
    int dev = 0, cus = 0, per = 0;
    hipGetDevice(&dev);
    hipDeviceGetAttribute(&cus, hipDeviceAttributeMultiprocessorCount, dev);
    hipOccupancyMaxActiveBlocksPerMultiprocessor(&per, hymba_mega, 512, SMEM_BYTES + 64 + 1024);
    if (per < 1) per = 1;
    grid_blocks = cus * per;
  }
  hipMemsetAsync((unsigned char*)d_ws + O_SMALL + S_BAR, 0, 16384, stream);
  int ph0 = 0, ph1 = NPH;
  void* args[] = {&p, &ph0, &ph1};
  hipError_t e = hipLaunchCooperativeKernel((void*)hymba_mega, dim3(grid_blocks), dim3(512), args, SMEM_BYTES + 64 + 1024, stream);
  if (e != hipSuccess) fprintf(stderr, "cooperative launch failed: %s (grid %d)\n", hipGetErrorString(e), grid_blocks);
}
```

```cpp
#include <hip/hip_runtime.h>
#include <hip/hip_cooperative_groups.h>
#include <stdint.h>
#include <stdio.h>
namespace cg = cooperative_groups;

typedef unsigned short u16;
typedef unsigned int u32;
typedef unsigned long long u64;
using bf16x8 = __attribute__((ext_vector_type(8))) short;
using f32x4 = __attribute__((ext_vector_type(4))) float;
using u32x4 = __attribute__((ext_vector_type(4))) unsigned int;
using u32x2 = __attribute__((ext_vector_type(2))) unsigned int;

constexpr int T = 16384, NTOK = 32768, DM = 1024, DFF = 2816;
constexpr int NPH = 33;
constexpr float EPS = 1e-6f;
constexpr float NEG = -1e30f;

constexpr size_t MiB = 1024ull * 1024ull;
constexpr size_t W_GU1 = 0;
constexpr size_t W_D1 = W_GU1 + 5632ull * 1024 * 2;
constexpr size_t W_IN = W_D1 + 1024ull * 2816 * 2;
constexpr size_t W_C1 = W_IN + 3584ull * 1024 * 2;
constexpr size_t W_C2 = W_C1 + 2ull * 256 * 2048 * 2;
constexpr size_t W_OUT = W_C2 + 2ull * 128 * 256 * 2;
constexpr size_t W_Q = W_OUT + 1024ull * 1024 * 2;
constexpr size_t W_K = W_Q + 1024ull * 1024 * 2;
constexpr size_t W_V = W_K + 1024ull * 1024 * 2;
constexpr size_t W_O = W_V + 1024ull * 1024 * 2;
constexpr size_t W_GU2 = W_O + 1024ull * 1024 * 2;
constexpr size_t W_D2 = W_GU2 + 5632ull * 1024 * 2;
constexpr size_t W_BIAS = W_D2 + 1024ull * 2816 * 2;
constexpr size_t W_END = W_BIAS + 16384;
static_assert(W_END <= 56 * MiB, "W region");
constexpr size_t O_HB = 56 * MiB;
constexpr size_t O_Y = O_HB + 64 * MiB;
constexpr size_t O_BIG = O_Y + 128 * MiB;
constexpr size_t SLACK = 4096;
constexpr size_t B_QN = 0;
constexpr size_t B_KCR = B_QN + 32 * MiB;
constexpr size_t B_VCR = B_KCR + 8 * MiB + SLACK;
constexpr size_t B_KS = B_VCR + 8 * MiB + SLACK;
constexpr size_t B_KW = B_KS + 8 * MiB + SLACK;
constexpr size_t B_VST = B_KW + 8 * MiB + SLACK;
constexpr size_t B_VWT = B_VST + 8 * MiB;
constexpr size_t B_GS = B_VWT + 8 * MiB;
constexpr size_t B_QR = B_GS + 3 * MiB;
constexpr size_t B_KR = B_QR + 32 * MiB;
constexpr size_t B_GR = B_KR + 32 * MiB;
constexpr size_t B_KRT = B_GR + 32 * MiB;
constexpr size_t B_VRT = B_KRT + 32 * MiB;
constexpr size_t B_END = B_VRT + 32 * MiB;
static_assert(B_END <= 244 * MiB, "BIG region");
constexpr size_t O_SMALL = O_BIG + 244 * MiB;
constexpr size_t S_HC = 0;
constexpr size_t S_KCC = S_HC + 4 * MiB;
constexpr size_t S_VCT = S_KCC + 512 * 1024;
constexpr size_t S_MEMN = S_VCT + 512 * 1024;
constexpr size_t S_KMEM = S_MEMN + 2 * MiB;
constexpr size_t S_VMEMT = S_KMEM + 1 * MiB;
constexpr size_t S_BAR = S_VMEMT + 1 * MiB;
constexpr size_t S_END = S_BAR + 16384;
constexpr size_t WS_NEED = O_SMALL + S_END;
static_assert(WS_NEED <= 512 * MiB, "workspace");

constexpr int KEYSTR = 260;
constexpr int SMEM_BYTES = 8 * 16 * KEYSTR * 4;
constexpr int LDSS = 72;

struct P {
  const float *x, *mem, *ffn1_pre_g, *ffn1_wg, *ffn1_wu, *ffn1_wd, *ffn1_post_g, *mix_pre_g, *w_in, *cmp_pe,
      *cmp_w1, *cmp_w2, *nsa_out_g, *ret_gn_g, *w_out, *mix_post_g, *xa_pre_g, *xa_mem_g, *xa_wq, *xa_wk, *xa_wv,
      *xa_wo, *xa_post_g, *ffn2_pre_g, *ffn2_wg, *ffn2_wu, *ffn2_wd, *ffn2_post_g;
  float* out;
  unsigned char* ws;
};

__device__ __forceinline__ u16 f2bf(float f) {
  u32 u = __float_as_uint(f);
  u += 0x7FFFu + ((u >> 16) & 1u);
  return (u16)(u >> 16);
}
__device__ __forceinline__ float bf2f(u16 h) { return __uint_as_float(((u32)h) << 16); }
typedef __bf16 bf16v2_t __attribute__((ext_vector_type(2)));
typedef float f32x2_t __attribute__((ext_vector_type(2)));
__device__ __forceinline__ u32 pack2(float a, float b) {
  f32x2_t v = {a, b};
  bf16v2_t h = __builtin_convertvector(v, bf16v2_t);
  return __builtin_bit_cast(u32, h);
}
__device__ __forceinline__ float silu_f(float v) { return v * __builtin_amdgcn_rcpf(1.f + __expf(-v)); }
__device__ __forceinline__ float sigm_f(float v) { return __builtin_amdgcn_rcpf(1.f + __expf(-v)); }
__device__ __forceinline__ float shx(float v, int m) { return __shfl_xor(v, m, 64); }
__device__ __forceinline__ float wave_sum(float v) {
#pragma unroll
  for (int o = 32; o >= 1; o >>= 1) v += __shfl_xor(v, o, 64);
  return v;
}
__device__ __forceinline__ f32x4 mfma16(bf16x8 a, bf16x8 b, f32x4 c) {
  return __builtin_amdgcn_mfma_f32_16x16x32_bf16(a, b, c, 0, 0, 0);
}
__device__ __forceinline__ bf16x8 ld8(const u16* p) { return *reinterpret_cast<const bf16x8*>(p); }
__device__ __forceinline__ bf16x8 ld4x2(const u16* p0, const u16* p1) {
  u32x2 a = *reinterpret_cast<const u32x2*>(p0);
  u32x2 b = *reinterpret_cast<const u32x2*>(p1);
  u32x4 r = {a.x, a.y, b.x, b.y};
  return __builtin_bit_cast(bf16x8, r);
}
__device__ __forceinline__ bf16x8 packp(f32x4 a, f32x4 b) {
  u32x4 r = {pack2(a[0], a[1]), pack2(a[2], a[3]), pack2(b[0], b[1]), pack2(b[2], b[3])};
  return __builtin_bit_cast(bf16x8, r);
}
__device__ __forceinline__ void st4bf(u16* p, f32x4 v) {
  u32x2 r = {pack2(v[0], v[1]), pack2(v[2], v[3])};
  *reinterpret_cast<u32x2*>(p) = r;
}
__device__ __forceinline__ f32x4 bf4_to_f32(u32x2 r) {
  return f32x4{__uint_as_float(r.x << 16), __uint_as_float(r.x & 0xFFFF0000u), __uint_as_float(r.y << 16), __uint_as_float(r.y & 0xFFFF0000u)};
}
__device__ __forceinline__ float ret_lg(int h) { return log2f(1.f - exp2f(-5.f - (float)h)); }

__device__ __forceinline__ int tidx() {
  int t = threadIdx.x;
  asm volatile("" : "+v"(t));
  return t;
}
__device__ __forceinline__ int bidx() {
  int t = blockIdx.x;
  asm volatile("" : "+s"(t));
  return t;
}
__device__ __forceinline__ int gdim() {
  int t = gridDim.x;
  asm volatile("" : "+s"(t));
  return t;
}
__device__ __forceinline__ int wmap(int mode, int n) {
  if (mode == 1) return (n >> 7) * 256 + (n & 127);
  if (mode == 2) return (n >> 7) * 256 + 128 + (n & 127);
  if (mode == 3) return n < 1280 ? n : (n < 1304 ? 3328 + (n - 1280) : n - 24);
  return n;
}
__device__ __forceinline__ void tconv(const float* __restrict__ src, int K, int N, u16* __restrict__ dst, int mode, int& tbase,
                      float* tile) {
  const int nkt = K >> 6, nnt = (N + 63) >> 6, ntl = nkt * nnt;
  const int G = gdim();
  int tl0 = (bidx() - (tbase % G) + G) % G;
  const int tid = tidx();
  for (int tl = tl0; tl < ntl; tl += G) {
    const int k0 = (tl / nnt) << 6, n0 = (tl % nnt) << 6;
#pragma unroll
    for (int i = 0; i < 2; ++i) {
      const int kk = (tid >> 4) + i * 32, nn = (tid & 15) * 4;
      f32x4 v = {0.f, 0.f, 0.f, 0.f};
      if (n0 + nn < N) v = *reinterpret_cast<const f32x4*>(src + (size_t)(k0 + kk) * N + n0 + nn);
      tile[kk * 65 + nn + 0] = v[0];
      tile[kk * 65 + nn + 1] = v[1];
      tile[kk * 65 + nn + 2] = v[2];
      tile[kk * 65 + nn + 3] = v[3];
    }
    __syncthreads();
    {
      int nn = tid >> 3, ch = tid & 7;
      if (n0 + nn < N) {
        u32x4 r;
        r.x = pack2(tile[(ch * 8 + 0) * 65 + nn], tile[(ch * 8 + 1) * 65 + nn]);
        r.y = pack2(tile[(ch * 8 + 2) * 65 + nn], tile[(ch * 8 + 3) * 65 + nn]);
        r.z = pack2(tile[(ch * 8 + 4) * 65 + nn], tile[(ch * 8 + 5) * 65 + nn]);
        r.w = pack2(tile[(ch * 8 + 6) * 65 + nn], tile[(ch * 8 + 7) * 65 + nn]);
        *reinterpret_cast<u32x4*>(dst + (size_t)wmap(mode, n0 + nn) * K + k0 + ch * 8) = r;
      }
    }
    __syncthreads();
  }
  tbase += ntl;
}

__device__ __forceinline__ void convert_layer(const P& p, int l, unsigned char* smem) {
  float* tile = reinterpret_cast<float*>(smem);
  unsigned char* W = p.ws;
  int tb = 0;
  tconv(p.ffn1_wg + (size_t)l * DM * DFF, DM, DFF, (u16*)(W + W_GU1), 1, tb, tile);
  tconv(p.ffn1_wu + (size_t)l * DM * DFF, DM, DFF, (u16*)(W + W_GU1), 2, tb, tile);
  tconv(p.ffn1_wd + (size_t)l * DFF * DM, DFF, DM, (u16*)(W + W_D1), 0, tb, tile);
  tconv(p.w_in + (size_t)l * DM * 3352, DM, 3352, (u16*)(W + W_IN), 3, tb, tile);
  tconv(p.cmp_w1 + (size_t)(l * 2 + 0) * 2048 * 256, 2048, 256, (u16*)(W + W_C1), 0, tb, tile);
  tconv(p.cmp_w1 + (size_t)(l * 2 + 1) * 2048 * 256, 2048, 256, (u16*)(W + W_C1) + 256 * 2048, 0, tb, tile);
  tconv(p.cmp_w2 + (size_t)(l * 2 + 0) * 256 * 64, 256, 64, (u16*)(W + W_C2), 0, tb, tile);
  tconv(p.cmp_w2 + (size_t)(l * 2 + 1) * 256 * 64, 256, 64, (u16*)(W + W_C2) + 128 * 256, 0, tb, tile);
  tconv(p.w_out + (size_t)l * DM * DM, DM, DM, (u16*)(W + W_OUT), 0, tb, tile);
  tconv(p.xa_wq + (size_t)l * DM * DM, DM, DM, (u16*)(W + W_Q), 0, tb, tile);
  tconv(p.xa_wk + (size_t)l * DM * DM, DM, DM, (u16*)(W + W_K), 0, tb, tile);
  tconv(p.xa_wv + (size_t)l * DM * DM, DM, DM, (u16*)(W + W_V), 0, tb, tile);
  tconv(p.xa_wo + (size_t)l * DM * DM, DM, DM, (u16*)(W + W_O), 0, tb, tile);
  tconv(p.ffn2_wg + (size_t)l * DM * DFF, DM, DFF, (u16*)(W + W_GU2), 1, tb, tile);
  tconv(p.ffn2_wu + (size_t)l * DM * DFF, DM, DFF, (u16*)(W + W_GU2), 2, tb, tile);
  tconv(p.ffn2_wd + (size_t)l * DFF * DM, DFF, DM, (u16*)(W + W_D2), 0, tb, tile);
  const int gt = bidx() * 512 + tidx(), nt = gdim() * 512;
  {
    u32* z = reinterpret_cast<u32*>((u16*)(W + W_IN) + (size_t)3352 * 1024);
    for (int i = gt; i < 232 * 512; i += nt) z[i] = 0u;
    for (int kv = 0; kv < 2; ++kv) {
      u32* z2 = reinterpret_cast<u32*>((u16*)(W + W_C2) + (size_t)kv * 128 * 256 + 64 * 256);
      for (int i = gt; i < 64 * 128; i += nt) z2[i] = 0u;
    }
  }
  {
    float* red = reinterpret_cast<float*>(smem);
    const int tid = tidx(), kg = tid >> 6, cl = tid & 63;
    for (int job = gdim() - 1 - bidx(); job < 64; job += gdim()) {
      const int kv = job >> 5, ct = (job >> 3) & 3, kb = job & 7;
      const float* pe = p.cmp_pe + (size_t)(l * 2 + kv) * 2048 + kb * 256 + kg * 32;
      const float* w1 = p.cmp_w1 + ((size_t)(l * 2 + kv) * 2048 + kb * 256 + kg * 32) * 256 + ct * 64 + cl;
      float s = 0.f;
#pragma unroll 8
      for (int i = 0; i < 32; ++i) s += pe[i] * w1[(size_t)i * 256];
      __syncthreads();
      red[kg * 64 + cl] = s;
      __syncthreads();
      if (tid < 64) {
        float a = 0.f;
#pragma unroll
        for (int j = 0; j < 8; ++j) a += red[j * 64 + tid];
        reinterpret_cast<float*>(W + W_BIAS)[(kv * 8 + kb) * 256 + ct * 64 + tid] = a;
      }
    }
    __syncthreads();
  }
}

__device__ __forceinline__ void bf8_to_f32(u32x4 r, f32x4& a, f32x4& b) {
  a = f32x4{__uint_as_float(r.x << 16), __uint_as_float(r.x & 0xFFFF0000u), __uint_as_float(r.y << 16), __uint_as_float(r.y & 0xFFFF0000u)};
  b = f32x4{__uint_as_float(r.z << 16), __uint_as_float(r.z & 0xFFFF0000u), __uint_as_float(r.w << 16), __uint_as_float(r.w & 0xFFFF0000u)};
}
__device__ __forceinline__ void st8bf_n(u16* p, f32x4 a, f32x4 b) {
  u32x4 r = {pack2(a[0], a[1]), pack2(a[2], a[3]), pack2(b[0], b[1]), pack2(b[2], b[3])};
  *reinterpret_cast<u32x4*>(p) = r;
}
__device__ __forceinline__ void norm_phase(const float* __restrict__ xin_f, const u16* __restrict__ xin_b, const u16* __restrict__ y,
                                           const float* __restrict__ gpost, float w, u16* __restrict__ xout_b,
                                           float* __restrict__ xout_f, float* __restrict__ xout_f2,
                                           const float* __restrict__ gpre, u16* __restrict__ hb, int ntok) {
  const int lane = tidx() & 63;
  const int gw = bidx() * 8 + __builtin_amdgcn_readfirstlane(tidx() >> 6), nw = gdim() * 8;
  for (int tok = gw; tok < ntok; tok += nw) {
    f32x4 xv[4];
    if (xin_b) {
#pragma unroll
      for (int i = 0; i < 2; ++i) {
        u32x4 xr = *reinterpret_cast<const u32x4*>(xin_b + (size_t)tok * 1024 + i * 512 + lane * 8);
        bf8_to_f32(xr, xv[2 * i], xv[2 * i + 1]);
      }
    } else {
#pragma unroll
      for (int i = 0; i < 2; ++i) {
        xv[2 * i] = *reinterpret_cast<const f32x4*>(xin_f + (size_t)tok * 1024 + i * 512 + lane * 8);
        xv[2 * i + 1] = *reinterpret_cast<const f32x4*>(xin_f + (size_t)tok * 1024 + i * 512 + lane * 8 + 4);
      }
    }
    if (y) {
      f32x4 yv[4];
      float ss = 0.f;
#pragma unroll
      for (int i = 0; i < 2; ++i) {
        u32x4 yr = *reinterpret_cast<const u32x4*>(y + (size_t)tok * 1024 + i * 512 + lane * 8);
        bf8_to_f32(yr, yv[2 * i], yv[2 * i + 1]);
      }
#pragma unroll
      for (int q = 0; q < 4; ++q) ss += yv[q][0] * yv[q][0] + yv[q][1] * yv[q][1] + yv[q][2] * yv[q][2] + yv[q][3] * yv[q][3];
      ss = wave_sum(ss);
      float r = rsqrtf(ss * (1.f / 1024.f) + EPS) * w;
#pragma unroll
      for (int q = 0; q < 4; ++q) {
        f32x4 g = *reinterpret_cast<const f32x4*>(gpost + (q >> 1) * 512 + lane * 8 + (q & 1) * 4);
        xv[q] += yv[q] * g * r;
      }
    }
    if (xout_b) {
#pragma unroll
      for (int i = 0; i < 2; ++i) st8bf_n(xout_b + (size_t)tok * 1024 + i * 512 + lane * 8, xv[2 * i], xv[2 * i + 1]);
    }
    if (xout_f) {
      float* o = (tok < 16384 ? xout_f : xout_f2) + (size_t)tok * 1024;
#pragma unroll
      for (int q = 0; q < 4; ++q) *reinterpret_cast<f32x4*>(o + (q >> 1) * 512 + lane * 8 + (q & 1) * 4) = xv[q];
    }
    if (hb) {
      float ss = 0.f;
#pragma unroll
      for (int q = 0; q < 4; ++q) ss += xv[q][0] * xv[q][0] + xv[q][1] * xv[q][1] + xv[q][2] * xv[q][2] + xv[q][3] * xv[q][3];
      ss = wave_sum(ss);
      float r = rsqrtf(ss * (1.f / 1024.f) + EPS);
      f32x4 hv[4];
#pragma unroll
      for (int q = 0; q < 4; ++q) {
        f32x4 g = *reinterpret_cast<const f32x4*>(gpre + (q >> 1) * 512 + lane * 8 + (q & 1) * 4);
        hv[q] = xv[q] * g * r;
      }
#pragma unroll
      for (int i = 0; i < 2; ++i) st8bf_n(hb + (size_t)tok * 1024 + i * 512 + lane * 8, hv[2 * i], hv[2 * i + 1]);
    }
  }
}

enum { EP_SWIGLU = 0, EP_F32 = 1, EP_WIN = 2, EP_C1 = 3, EP_C2K = 4, EP_C2V = 5, EP_BF16 = 6, EP_VMEMT = 7 };

template <int MODE>
__device__ __forceinline__ void epi_store(const P& p, int aux, float scale, void* outp, int ldo, int row, int col,
                                          f32x4 v) {
  unsigned char* ws = p.ws;
  if constexpr (MODE == EP_F32) {
    float* o = (float*)outp;
#pragma unroll
    for (int i = 0; i < 4; ++i) o[(size_t)(row + i) * ldo + col] = v[i];
  } else if constexpr (MODE == EP_BF16) {
    u16* o = (u16*)outp;
#pragma unroll
    for (int i = 0; i < 4; ++i) o[(size_t)(row + i) * ldo + col] = f2bf(v[i] * scale);
  } else if constexpr (MODE == EP_C1) {
    u16* o = (u16*)outp;
    float bia = 0.f;
#pragma unroll
    for (int j = 0; j < 8; ++j) bia += reinterpret_cast<const float*>(ws + W_BIAS)[(aux * 8 + j) * 256 + col];
#pragma unroll
    for (int i = 0; i < 4; ++i) o[(size_t)(row + i) * 256 + col] = f2bf(silu_f(v[i] + bia));
  } else if constexpr (MODE == EP_C2K) {
    if (col < 64) {
      u16* o = (u16*)outp;
#pragma unroll
      for (int i = 0; i < 4; ++i) o[(size_t)(row + i) * 64 + col] = f2bf(v[i]);
    }
  } else if constexpr (MODE == EP_C2V) {
    if (col < 64) {
      u16* o = (u16*)outp;
      int bg = row >> 10, n = row & 1023;
      st4bf(o + (size_t)bg * 65536 + (size_t)(n >> 6) * 4096 + col * 64 + (n & 63), v);
    }
  } else if constexpr (MODE == EP_VMEMT) {
    u16* o = (u16*)outp;
    int b = row >> 8, m = row & 255;
    st4bf(o + ((size_t)b * 1024 + col) * 256 + m, v);
  } else if constexpr (MODE == EP_WIN) {
    unsigned char* big = ws + O_BIG;
    const int b = row >> 14, t = row & 16383;
    if (col < 512) {
      u16* o = (u16*)(big + B_QN);
#pragma unroll
      for (int i = 0; i < 4; ++i) o[(size_t)(row + i) * 512 + col] = f2bf(v[i] * 0.125f);
    } else if (col < 1280) {
      const int s = (col - 512) >> 7, cc = (col - 512) & 127, g = cc >> 6, d = cc & 63, bg = b * 2 + g;
      if (s == 3 || s == 5) {
        u16* o = (u16*)(big + (s == 3 ? B_VST : B_VWT));
        st4bf(o + ((size_t)(bg * 256 + (t >> 6)) * 4096 + d * 64 + (t & 63)), v);
      } else {
        u16* o = (u16*)(big + (s == 0 ? B_KCR : (s == 1 ? B_VCR : (s == 2 ? B_KS : B_KW))));
        o += ((size_t)bg * T + t) * 64 + d;
#pragma unroll
        for (int i = 0; i < 4; ++i) o[i * 64] = f2bf(v[i]);
      }
    } else if (col < 3328) {
      const int cr = col - 1280, wh = cr >> 9, cc = cr & 511, h = cc >> 7, d = cc & 127;
      const float s128 = 0.08838834764831845f;
      if (wh == 0) {
        u16* o = (u16*)(big + B_QR);
#pragma unroll
        for (int i = 0; i < 4; ++i) o[(size_t)(row + i) * 512 + cc] = f2bf(v[i]);
      } else if (wh == 1) {
        u16* o = (u16*)(big + B_KR);
#pragma unroll
        for (int i = 0; i < 4; ++i) o[(size_t)(row + i) * 512 + cc] = f2bf(v[i] * s128);
        u16* ot = (u16*)(big + B_KRT);
        const float lg = ret_lg(h);
        const int tm = t & 127;
        f32x4 w;
#pragma unroll
        for (int i = 0; i < 4; ++i) w[i] = v[i] * s128 * exp2f((float)(127 - tm - i) * lg);
        st4bf(ot + ((size_t)((b * 4 + h) * 128 + (t >> 7)) * 16384 + d * 128 + tm), w);
      } else if (wh == 2) {
        u16* ot = (u16*)(big + B_VRT);
        st4bf(ot + ((size_t)((b * 4 + h) * 128 + (t >> 7)) * 16384 + d * 128 + (t & 127)), v);
      } else {
        u16* o = (u16*)(big + B_GR);
#pragma unroll
        for (int i = 0; i < 4; ++i) o[(size_t)(row + i) * 512 + cc] = f2bf(silu_f(v[i]));
      }
    } else if (col < 3352) {
      float* o = (float*)(big + B_GS);
#pragma unroll
      for (int i = 0; i < 4; ++i) o[(size_t)(row + i) * 24 + (col - 3328)] = sigm_f(v[i]);
    }
  }
}

template <int MODE>
__device__ __forceinline__ void gemm_tile(const P& p, int aux, float scale, void* outp, int ldo, const u16* __restrict__ A, size_t lda,
                          const u16* __restrict__ Bt, size_t ldb, int K, int brow, int bcol, u16* sm) {
  const int tid = tidx(), lane = tid & 63, wid = __builtin_amdgcn_readfirstlane(tid >> 6);
  const int wr = wid >> 1, wc = wid & 1, fr = lane & 15, fq = lane >> 4;
  u16* smA = sm;
  u16* smB = sm + 2 * 256 * LDSS;
  f32x4 acc[4][4];
#pragma unroll
  for (int m = 0; m < 4; ++m)
#pragma unroll
    for (int n = 0; n < 4; ++n) acc[m][n] = f32x4{0.f, 0.f, 0.f, 0.f};
  u32x4 ra[4], rb[2];
  const int nt = K >> 6;
  auto gload = [&](int kt) {
#pragma unroll
    for (int i = 0; i < 4; ++i) {
      int c = tid + i * 512;
      ra[i] = *reinterpret_cast<const u32x4*>(A + (size_t)(brow + (c >> 3)) * lda + (size_t)kt * 64 + (c & 7) * 8);
    }
#pragma unroll
    for (int i = 0; i < 2; ++i) {
      int c = tid + i * 512;
      rb[i] = *reinterpret_cast<const u32x4*>(Bt + (size_t)(bcol + (c >> 3)) * ldb + (size_t)kt * 64 + (c & 7) * 8);
    }
  };
  auto swrite = [&](int buf) {
#pragma unroll
    for (int i = 0; i < 4; ++i) {
      int c = tid + i * 512;
      *reinterpret_cast<u32x4*>(smA + buf * 256 * LDSS + (c >> 3) * LDSS + (c & 7) * 8) = ra[i];
    }
#pragma unroll
    for (int i = 0; i < 2; ++i) {
      int c = tid + i * 512;
      *reinterpret_cast<u32x4*>(smB + buf * 128 * LDSS + (c >> 3) * LDSS + (c & 7) * 8) = rb[i];
    }
  };
  gload(0);
  swrite(0);
  __syncthreads();
  for (int kt = 0; kt < nt; ++kt) {
    const int buf = kt & 1;
    if (kt + 1 < nt) gload(kt + 1);
    const u16* a0 = smA + buf * 256 * LDSS + (wr * 64 + fr) * LDSS + fq * 8;
    const u16* b0 = smB + buf * 128 * LDSS + (wc * 64 + fr) * LDSS + fq * 8;
#pragma unroll
    for (int ks = 0; ks < 2; ++ks) {
      bf16x8 af[4], bfr[4];
#pragma unroll
      for (int m = 0; m < 4; ++m) af[m] = ld8(a0 + m * 16 * LDSS + ks * 32);
#pragma unroll
      for (int n = 0; n < 4; ++n) bfr[n] = ld8(b0 + n * 16 * LDSS + ks * 32);
#pragma unroll
      for (int m = 0; m < 4; ++m)
#pragma unroll
        for (int n = 0; n < 4; ++n) acc[m][n] = mfma16(af[m], bfr[n], acc[m][n]);
    }
    if (kt + 1 < nt) swrite(buf ^ 1);
    __syncthreads();
  }
#pragma unroll
  for (int m = 0; m < 4; ++m) {
    const int row = brow + wr * 64 + m * 16 + fq * 4;
    if constexpr (MODE == EP_SWIGLU) {
#pragma unroll
      for (int n = 0; n < 4; n += 2) {
        const int cb = bcol + wc * 64 + n * 16;
        const int oc = (cb >> 5) * 16 + fr;
        u16* o = (u16*)outp;
#pragma unroll
        for (int i = 0; i < 4; ++i)
          o[(size_t)(row + i) * DFF + oc] = f2bf(silu_f(acc[m][n][i]) * acc[m][n + 1][i]);
      }
    } else {
#pragma unroll
      for (int n = 0; n < 4; ++n)
        epi_store<MODE>(p, aux, scale, outp, ldo, row, bcol + wc * 64 + n * 16 + fr, acc[m][n]);
    }
  }
}

template <int MODE>
__device__ __forceinline__ void gemm_phase(const P& p, int aux, float scale, void* outp, int ldo, const u16* A, size_t lda,
                           const u16* Bt, size_t ldb, int M, int N, int K, u16* sm, int rev) {
  const int nNt = N >> 7, ntl = (M >> 8) * nNt;
  const int bid = (bidx() + gdim() - rev) % gdim();
  for (int tl = bid; tl < ntl; tl += gdim())
    gemm_tile<MODE>(p, aux, scale, outp, ldo, A, lda, Bt, ldb, K, (tl / nNt) << 8, (tl % nNt) << 7, sm);
}

namespace pg8 {
#define PG8_LAS __attribute__((address_space(3)))
typedef unsigned short bf16_t;
typedef short bf16x8 __attribute__((ext_vector_type(8)));
typedef float f32x4 __attribute__((ext_vector_type(4)));
typedef unsigned u32x4 __attribute__((ext_vector_type(4)));
constexpr int BM = 256, BK = 64, HALF = 128, HTB = HALF * BK * 2  , STAGE_BYTES = 8 * HTB, NXCD = 8, WGM = 8;

__host__ __device__ __forceinline__ int lds_byte(int r, int c) { const int st = (r >> 4) * 2 + (c >> 5), rr = r & 15, cc = c & 31, ob = rr * 64 + cc * 2; return st * 1024 + (ob ^ (((ob >> 9) & 1) << 5)); }
__host__ __device__ __forceinline__ void stage_rc(int b, int& R, int& C) { const int st = b / 1024, sb = b % 1024, swz = sb ^ (((sb >> 9) & 1) << 5); R = (st >> 1) * 16 + swz / 64; C = (st & 1) * 32 + (swz % 64) / 2; }
__host__ __device__ __forceinline__ int perm32(int rho) { const int n = rho >> 4, i = rho & 15; return 8 * (i >> 2) + 4 * n + (i & 3); }

struct Unit { int pm, pn; };
struct Gemm { const bf16_t* A; const bf16_t* Bt; int M, N, K, lda, ldb; };

struct StaticOrder {
    int nM, nN, nwg, G, c;
    __host__ __device__ void init(int M, int N, int G_, int c_) { nM = M / BM; nN = N / BM; nwg = nM * nN; G = G_; c = c_; }
    __host__ __device__ bool next(int i, Unit& u) const {
        const long L = (long)i * G + c; if (L >= nwg) return false;
        int wgid = (int)L; { const int q = nwg / NXCD, r = nwg % NXCD, xcd = wgid % NXCD, off = wgid / NXCD; wgid = (xcd < r ? xcd * (q + 1) : r * (q + 1) + (xcd - r) * q) + off; }
        const int nig = WGM * nN, gid = wgid / nig, fm = gid * WGM, gsz = (nM - fm) < WGM ? (nM - fm) : WGM;
        u.pm = fm + ((wgid % nig) % gsz); u.pn = (wgid % nig) / gsz; return true;
    }
    __device__ __forceinline__ void a_ready(const Unit&) const {}
    __device__ __forceinline__ void done(const Unit&) const {}
};
__device__ __forceinline__ unsigned cvt_pk_bf16(float lo, float hi) { unsigned r; asm volatile("v_cvt_pk_bf16_f32 %0, %1, %2" : "=v"(r) : "v"(lo), "v"(hi)); return r; }
template <class Epi, class Sched, bool STAMP = false>
__device__ __forceinline__ void gemm_phase(PG8_LAS unsigned char* lds, const Gemm g, const Sched& S, const Epi& E, unsigned long long* stamps) {
    const int tid = tidx(), wid = __builtin_amdgcn_readfirstlane(tid >> 6), lane = tid & 63, wr = wid >> 2, wc = wid & 3, fr = lane & 15, fq = lane >> 4;
    const int K = g.K, nt = K / BK;
    int ts_lo = 0, ts_hi = 0, nts = 0; const unsigned long long rt_entry = STAMP ? (unsigned long long)wall_clock64() : 0ull;
#define PG8_STAMP() do { if (STAMP && wid == 0 && nts < 64) { const unsigned long long _c = (unsigned long long)clock64(); \
        ts_lo = (lane == nts) ? (int)(unsigned)_c : ts_lo; ts_hi = (lane == nts) ? (int)(unsigned)(_c >> 32) : ts_hi; ++nts; } } while (0)
    PG8_STAMP();
    unsigned voffA[2], voffB[2];
#pragma unroll
    for (int i = 0; i < 2; ++i) { int R, C; stage_rc(tid * 16 + i * 8192, R, C); const int Rb = Epi::PERM ? ((R & ~31) + perm32(R & 31)) : R;
        voffA[i] = (unsigned)(R * g.lda + C) * 2u; voffB[i] = (unsigned)(Rb * g.ldb + C) * 2u; }
    const size_t kstep = (size_t)(BK * 2);
    const size_t hstepA = (size_t)HALF * g.lda * 2, hstepB = (size_t)HALF * g.ldb * 2;
    const size_t tstepA = 2 * hstepA, tstepB = 2 * hstepB;
    const unsigned ldsw = (unsigned)wid * 1024u;
    const int aoff = lds_byte(wr * 64 + fr, fq * 8), boff = lds_byte(wc * 32 + fr, fq * 8);
#define PG8_SA(b, h) (((b) * 2 + (h)) * HTB)
#define PG8_SB(b, h) ((4 + (b) * 2 + (h)) * HTB)
#define PG8_STAGE(bufoff, gbase, voff) do { _Pragma("unroll") for (int _i = 0; _i < 2; ++_i) \
        __builtin_amdgcn_global_load_lds((const unsigned*)((const char*)(gbase) + (voff)[_i]), (PG8_LAS unsigned*)(lds + (bufoff) + ldsw + _i * 8192), 16, 0, 0); } while (0)
#define PG8_LDA(dst, b, h) do { _Pragma("unroll") for (int m = 0; m < 4; ++m) _Pragma("unroll") for (int k = 0; k < 2; ++k) dst[m][k] = *(const PG8_LAS bf16x8*)(lds + PG8_SA(b, h) + aoff + m * 2048 + k * 1024); } while (0)
#define PG8_LDB(dst, b, h) do { _Pragma("unroll") for (int n = 0; n < 2; ++n) _Pragma("unroll") for (int k = 0; k < 2; ++k) dst[n][k] = *(const PG8_LAS bf16x8*)(lds + PG8_SB(b, h) + boff + n * 2048 + k * 1024); } while (0)
#define PG8_MMA(ai, bj, At, Bt) do { __builtin_amdgcn_s_setprio(1); _Pragma("unroll") for (int m = 0; m < 4; ++m) _Pragma("unroll") for (int n = 0; n < 2; ++n) _Pragma("unroll") for (int k = 0; k < 2; ++k) \
        acc[ai][bj][m][n] = __builtin_amdgcn_mfma_f32_16x16x32_bf16(Bt[n][k], At[m][k], acc[ai][bj][m][n], 0, 0, 0); __builtin_amdgcn_s_setprio(0); } while (0)
#define PG8_WAIT_V(n) asm volatile("s_waitcnt vmcnt(" #n ")" ::: "memory")
#define PG8_WAIT_L(n) asm volatile("s_waitcnt lgkmcnt(" #n ")" ::: "memory")
#define PG8_BAR __builtin_amdgcn_s_barrier()
#define PG8_SCHED __builtin_amdgcn_sched_barrier(0)
    Unit cur, nxt; int ui = 0;
    if (!S.next(0, cur)) return;
    f32x4 acc[2][2][4][2];
#pragma unroll
    for (int a = 0; a < 2; ++a)
#pragma unroll
        for (int b = 0; b < 2; ++b)
#pragma unroll
            for (int m = 0; m < 4; ++m)
#pragma unroll
                for (int n = 0; n < 2; ++n) acc[a][b][m][n] = (f32x4){0.f, 0.f, 0.f, 0.f};
    bf16x8 At[4][2], B0[2][2], B1[2][2];
    const char* cA = (const char*)g.A + (size_t)cur.pm * tstepA; const char* cB = (const char*)g.Bt + (size_t)cur.pn * tstepB;
    S.a_ready(cur);
    PG8_STAGE(PG8_SB(0, 0), cB, voffB); PG8_STAGE(PG8_SA(0, 0), cA, voffA); PG8_STAGE(PG8_SB(0, 1), cB + hstepB, voffB); PG8_STAGE(PG8_SA(0, 1), cA + hstepA, voffA);
    if (wr == 1) PG8_BAR;
    PG8_WAIT_V(4); PG8_BAR;
    PG8_STAGE(PG8_SB(1, 0), cB + kstep, voffB); PG8_STAGE(PG8_SA(1, 0), cA + kstep, voffA); PG8_STAGE(PG8_SB(1, 1), cB + hstepB + kstep, voffB);
    PG8_WAIT_V(6); PG8_BAR;
    PG8_STAMP();
    for (;;) {
        const bool has_next = S.next(ui + 1, nxt);
        const char* nA = has_next ? (const char*)g.A + (size_t)nxt.pm * tstepA : cA; const char* nB = has_next ? (const char*)g.Bt + (size_t)nxt.pn * tstepB : cB;
        for (int t = 0; t < nt; t += 2) {
            const bool last = (t == nt - 2);
            const char* a1 = cA + (size_t)(t + 1) * kstep;
            const char* a2 = last ? nA : cA + (size_t)(t + 2) * kstep; const char* b2 = last ? nB : cB + (size_t)(t + 2) * kstep;
            const char* a3 = a2 + kstep; const char* b3 = b2 + kstep;
            if (last && has_next) S.a_ready(nxt);
            PG8_LDB(B0, 0, 0); PG8_SCHED; PG8_LDA(At, 0, 0); PG8_STAGE(PG8_SA(1, 1), a1 + hstepA, voffA);
            PG8_WAIT_L(8); PG8_BAR; PG8_WAIT_L(0); PG8_MMA(0, 0, At, B0); PG8_BAR; PG8_SCHED;
            PG8_LDB(B1, 0, 1); PG8_STAGE(PG8_SB(0, 0), b2, voffB);
            PG8_BAR; PG8_WAIT_L(0); PG8_MMA(0, 1, At, B1); PG8_BAR;
            PG8_LDA(At, 0, 1); PG8_STAGE(PG8_SA(0, 0), a2, voffA);
            PG8_BAR; PG8_WAIT_L(0); PG8_MMA(1, 0, At, B0); PG8_BAR; PG8_SCHED;
            PG8_STAGE(PG8_SB(0, 1), b2 + hstepB, voffB);
            PG8_WAIT_V(6); PG8_BAR; PG8_MMA(1, 1, At, B1); PG8_BAR;
            PG8_LDB(B0, 1, 0); PG8_SCHED; PG8_LDA(At, 1, 0); PG8_STAGE(PG8_SA(0, 1), a2 + hstepA, voffA);
            PG8_WAIT_L(8); PG8_BAR; PG8_WAIT_L(0); PG8_MMA(0, 0, At, B0); PG8_BAR; PG8_SCHED;
            PG8_LDB(B1, 1, 1); PG8_STAGE(PG8_SB(1, 0), b3, voffB);
            PG8_BAR; PG8_WAIT_L(0); PG8_MMA(0, 1, At, B1); PG8_BAR;
            PG8_LDA(At, 1, 1); PG8_STAGE(PG8_SA(1, 0), a3, voffA);
            PG8_BAR; PG8_WAIT_L(0); PG8_MMA(1, 0, At, B0); PG8_BAR; PG8_SCHED;
            PG8_STAGE(PG8_SB(1, 1), b3 + hstepB, voffB);
            PG8_WAIT_V(6); PG8_BAR; PG8_MMA(1, 1, At, B1); PG8_BAR;
        }
        PG8_STAMP();
        if constexpr (!Epi::AFTER_DRAIN) { E(acc, cur, wr, wc, fr, fq); S.done(cur); }
        PG8_STAMP();
        if (!has_next) break;
#pragma unroll
        for (int a = 0; a < 2; ++a)
#pragma unroll
            for (int b = 0; b < 2; ++b)
#pragma unroll
                for (int m = 0; m < 4; ++m)
#pragma unroll
                    for (int n = 0; n < 2; ++n) acc[a][b][m][n] = (f32x4){0.f, 0.f, 0.f, 0.f};
        cur = nxt; cA = nA; cB = nB; ++ui;
    }
    PG8_WAIT_V(0);
    if (wr == 0) PG8_BAR;
    PG8_BAR;
    if constexpr (Epi::AFTER_DRAIN) { E.fused(acc, cur, wr, wc, fr, fq, lds, wid, lane); S.done(cur); }
    PG8_STAMP();
    if (STAMP && wid == 0) { stamps[lane] = lane < nts ? (((unsigned long long)(unsigned)ts_hi << 32) | (unsigned)ts_lo) : 0ull;
        if (lane == 62) stamps[62] = rt_entry; if (lane == 63) stamps[63] = (unsigned long long)wall_clock64(); }
#undef PG8_STAMP
#undef PG8_SA
#undef PG8_SB
#undef PG8_STAGE
#undef PG8_LDA
#undef PG8_LDB
#undef PG8_MMA
#undef PG8_WAIT_V
#undef PG8_WAIT_L
#undef PG8_BAR
#undef PG8_SCHED
}
}

__device__ __forceinline__ void st8bf(u16* p, f32x4 a, f32x4 b) {
  u32x4 r = {pack2(a[0], a[1]), pack2(a[2], a[3]), pack2(b[0], b[1]), pack2(b[2], b[3])};
  *reinterpret_cast<u32x4*>(p) = r;
}
struct EpiY {
  static constexpr bool PERM = true, AFTER_DRAIN = false;
  u16* C; int ldc;
  __device__ __forceinline__ void operator()(const pg8::f32x4 (&acc)[2][2][4][2], const pg8::Unit& u, int wr, int wc, int fr, int fq) const {
    const int row0 = u.pm * 256 + wr * 64 + fr, col0 = u.pn * 256 + wc * 32 + 8 * fq;
#pragma unroll
    for (int ai = 0; ai < 2; ++ai)
#pragma unroll
      for (int m = 0; m < 4; ++m) {
        u16* rowp = C + (size_t)(row0 + ai * 128 + m * 16) * ldc + col0;
#pragma unroll
        for (int bj = 0; bj < 2; ++bj) st8bf(rowp + bj * 128, acc[ai][bj][m][0], acc[ai][bj][m][1]);
      }
  }
};
struct EpiSwiglu {
  static constexpr bool PERM = true, AFTER_DRAIN = false;
  u16* O;
  __device__ __forceinline__ void operator()(const pg8::f32x4 (&acc)[2][2][4][2], const pg8::Unit& u, int wr, int wc, int fr, int fq) const {
    const int row0 = u.pm * 256 + wr * 64 + fr, hb = u.pn * 128 + wc * 32 + 8 * fq;
#pragma unroll
    for (int ai = 0; ai < 2; ++ai)
#pragma unroll
      for (int m = 0; m < 4; ++m) {
        f32x4 v0, v1;
#pragma unroll
        for (int i = 0; i < 4; ++i) {
          v0[i] = silu_f(acc[ai][0][m][0][i]) * acc[ai][1][m][0][i];
          v1[i] = silu_f(acc[ai][0][m][1][i]) * acc[ai][1][m][1][i];
        }
        st8bf(O + (size_t)(row0 + ai * 128 + m * 16) * DFF + hb, v0, v1);
      }
  }
};
struct EpiQ {
  static constexpr bool PERM = true, AFTER_DRAIN = false;
  u16* O; float scale;
  __device__ __forceinline__ void operator()(const pg8::f32x4 (&acc)[2][2][4][2], const pg8::Unit& u, int wr, int wc, int fr, int fq) const {
    const int row0 = u.pm * 256 + wr * 64 + fr, col0 = u.pn * 256 + wc * 32 + 8 * fq;
#pragma unroll
    for (int ai = 0; ai < 2; ++ai)
#pragma unroll
      for (int m = 0; m < 4; ++m) {
        u16* rowp = O + (size_t)(row0 + ai * 128 + m * 16) * 1024 + col0;
#pragma unroll
        for (int bj = 0; bj < 2; ++bj) st8bf(rowp + bj * 128, acc[ai][bj][m][0] * scale, acc[ai][bj][m][1] * scale);
      }
  }
};
struct EpiWin {
  static constexpr bool PERM = true, AFTER_DRAIN = false;
  unsigned char* big;
  __device__ __forceinline__ void operator()(const pg8::f32x4 (&acc)[2][2][4][2], const pg8::Unit& u, int wr, int wc, int fr, int fq) const {
    const int row0 = u.pm * 256 + wr * 64 + fr;
    const int b = u.pm >> 6;
    const float s128 = 0.08838834764831845f;
#pragma unroll
    for (int bj = 0; bj < 2; ++bj) {
      const int cb = u.pn * 256 + bj * 128 + wc * 32;
      if (cb >= 3352) continue;
      u16* rmb = nullptr; int ld = 0; float rsc = 1.f; bool act = false;
      u16* trb = nullptr; int X = 0, sh = 6; bool dec = false; float lg = 0.f; int dcol = 0;
      if (cb < 512) { rmb = (u16*)(big + B_QN) + cb; ld = 512; rsc = 0.125f * 1.4426950408889634f; }
      else if (cb < 1280) {
        const int s = (cb - 512) >> 7, cc = (cb - 512) & 127, g = cc >> 6, d = cc & 63, bg = b * 2 + g;
        if (s == 3 || s == 5) { trb = (u16*)(big + (s == 3 ? B_VST : B_VWT)); X = bg * 256; sh = 6; dcol = d; }
        else { rmb = (u16*)(big + (s == 0 ? B_KCR : (s == 1 ? B_VCR : (s == 2 ? B_KS : B_KW)))) + (size_t)(b + g) * T * 64 + d; ld = 64; }
      } else if (cb < 3328) {
        const int cr = cb - 1280, wh = cr >> 9, cc = cr & 511, h = cc >> 7, d = cc & 127;
        if (wh == 0) { rmb = (u16*)(big + B_QR) + cc; ld = 512; }
        else if (wh == 1) { rmb = (u16*)(big + B_KR) + cc; ld = 512; rsc = s128;
                            trb = (u16*)(big + B_KRT); X = (b * 4 + h) * 128; sh = 7; dcol = d; dec = true; lg = ret_lg(h); }
        else if (wh == 2) { trb = (u16*)(big + B_VRT); X = (b * 4 + h) * 128; sh = 7; dcol = d; }
        else { rmb = (u16*)(big + B_GR) + cc; ld = 512; act = true; }
      }
      if (cb >= 3328) {
#pragma unroll
        for (int n = 0; n < 2; ++n) {
          const int gc = 8 * fq + 4 * n;
          if (gc < 24) {
#pragma unroll
            for (int ai = 0; ai < 2; ++ai)
#pragma unroll
              for (int m = 0; m < 4; ++m) {
                const int row = row0 + ai * 128 + m * 16;
                f32x4 v = acc[ai][bj][m][n], w4;
#pragma unroll
                for (int i = 0; i < 4; ++i) w4[i] = sigm_f(v[i]);
                *(f32x4*)((float*)(big + B_GS) + (size_t)row * 24 + gc) = w4;
              }
          }
        }
        continue;
      }
      if (rmb) {
#pragma unroll
        for (int ai = 0; ai < 2; ++ai)
#pragma unroll
          for (int m = 0; m < 4; ++m) {
            const int row = row0 + ai * 128 + m * 16;
            f32x4 v0 = acc[ai][bj][m][0] * rsc, v1 = acc[ai][bj][m][1] * rsc;
            if (act) {
#pragma unroll
              for (int i = 0; i < 4; ++i) { v0[i] = silu_f(v0[i]); v1[i] = silu_f(v1[i]); }
            }
            st8bf(rmb + (size_t)row * ld + 8 * fq, v0, v1);
          }
      }
      if (trb) {
        const int msk = (1 << sh) - 1;
#pragma unroll
        for (int n = 0; n < 2; ++n)
#pragma unroll
          for (int ai = 0; ai < 2; ++ai)
#pragma unroll
            for (int m = 0; m < 4; ++m) {
              const int t = (row0 + ai * 128 + m * 16) & 16383;
              u16* o = trb + ((size_t)(X + (t >> sh)) << (2 * sh)) + (t & msk) + ((size_t)(dcol + 8 * fq + 4 * n) << sh);
              const float sc = dec ? s128 * exp2f((float)(127 - (t & 127)) * lg) : 1.f;
              f32x4 v = acc[ai][bj][m][n] * sc;
              const u32 p01 = pack2(v[0], v[1]), p23 = pack2(v[2], v[3]);
              o[0] = (u16)p01;
              o[(size_t)1 << sh] = (u16)(p01 >> 16);
              o[(size_t)2 << sh] = (u16)p23;
              o[(size_t)3 << sh] = (u16)(p23 >> 16);
            }
      }
    }
  }
};
template <class Epi>
__device__ __forceinline__ void big_gemm(unsigned char* smem, const u16* A, const u16* Bt, int M, int N, int K, const Epi& E,
                                         int lda = 0, int boff = 0) {
  pg8::Gemm g{A, Bt, M, N, K, lda ? lda : K, K};
  pg8::StaticOrder S;
  const int G = gdim();
  S.init(M, N, G, (bidx() + G - boff) % G);
  pg8::gemm_phase<Epi, pg8::StaticOrder, false>((PG8_LAS unsigned char*)smem, g, S, E, nullptr);
}
struct EpiC1 {
  static constexpr bool PERM = false, AFTER_DRAIN = false;
  u16* O; const float* bias;
  __device__ __forceinline__ void operator()(const pg8::f32x4 (&acc)[2][2][4][2], const pg8::Unit& u, int wr, int wc, int fr, int fq) const {
    const int row0 = u.pm * 256 + wr * 64 + fr, col0 = wc * 32 + 4 * fq;
#pragma unroll
    for (int bj = 0; bj < 2; ++bj)
#pragma unroll
      for (int n = 0; n < 2; ++n) {
        const int col = col0 + bj * 128 + n * 16;
        f32x4 bv = {0.f, 0.f, 0.f, 0.f};
#pragma unroll 1
        for (int j = 0; j < 8; ++j) bv += *(const f32x4*)(bias + j * 256 + col);
#pragma unroll
        for (int ai = 0; ai < 2; ++ai)
#pragma unroll
          for (int m = 0; m < 4; ++m) {
            f32x4 v = acc[ai][bj][m][n] + bv, w;
#pragma unroll
            for (int i = 0; i < 4; ++i) w[i] = silu_f(v[i]);
            st4bf(O + (size_t)(row0 + ai * 128 + m * 16) * 256 + col, w);
          }
      }
  }
};

__device__ __forceinline__ void ld_kfp(const u16* __restrict__ kp, bf16x8 (&Kf)[2][2], int krow0, int fq) {
#pragma unroll
  for (int tl = 0; tl < 2; ++tl)
#pragma unroll
    for (int ks = 0; ks < 2; ++ks) Kf[tl][ks] = ld8(kp + (krow0 + tl * 4) * 64 + ks * 32 + fq * 8);
}
__device__ __forceinline__ void ld_vfp(const u16* __restrict__ vp, bf16x8 (&Vf)[4], int fr, int fq) {
#pragma unroll
  for (int dt = 0; dt < 4; ++dt) Vf[dt] = ld8(vp + ((dt >> 1) * 32 + (fr >> 2) * 8 + (dt & 1) * 4 + (fr & 3)) * 64 + fq * 8);
}
__device__ __forceinline__ void qk_r(const bf16x8 (&Kf)[2][2], const bf16x8 (&Qr)[2], f32x4& s0, f32x4& s1) {
  f32x4 z = {0.f, 0.f, 0.f, 0.f};
  s0 = mfma16(Kf[0][0], Qr[0], z);
  s0 = mfma16(Kf[0][1], Qr[1], s0);
  s1 = mfma16(Kf[1][0], Qr[0], z);
  s1 = mfma16(Kf[1][1], Qr[1], s1);
}
__device__ __forceinline__ void pv_tiles(const bf16x8 (&Vf)[4], const bf16x8 (&Pb)[4], f32x4 (&O)[4][4]) {
#pragma unroll
  for (int dt = 0; dt < 4; ++dt)
#pragma unroll
    for (int r = 0; r < 4; ++r) O[r][dt] = mfma16(Vf[dt], Pb[r], O[r][dt]);
}

template <int MODE, bool MASKED>
__device__ __forceinline__ void att_step(const bf16x8 (&Kc)[2][2], const bf16x8 (&Vc)[4], int d0, bool selq, const bf16x8* qlds,
                                         int lane, const float (&slope)[4], float (&m)[4], float (&ls)[4], f32x4 (&O)[4][4]) {
  float fd[2][4];
#pragma unroll
  for (int tl = 0; tl < 2; ++tl)
#pragma unroll
    for (int i = 0; i < 4; ++i) {
      const int dist = d0 - tl * 4 - i;
      bool v;
      if (MODE == 1) v = selq && (dist >= 0);
      else v = (dist >= 0) && (dist < 512);
      fd[tl][i] = (MASKED && !v) ? __builtin_inff() : (float)dist;
    }
  bf16x8 Pb[4];
#pragma unroll
  for (int r = 0; r < 4; ++r) {
    f32x4 sv[2];
    bf16x8 Qr[2];
    Qr[0] = qlds[(r * 2 + 0) * 64 + lane];
    Qr[1] = qlds[(r * 2 + 1) * 64 + lane];
    qk_r(Kc, Qr, sv[0], sv[1]);
    float mx = NEG;
#pragma unroll
    for (int tl = 0; tl < 2; ++tl)
#pragma unroll
      for (int i = 0; i < 4; ++i) {
        const float sc = __builtin_fmaf(-slope[r], fd[tl][i], sv[tl][i]);
        sv[tl][i] = sc;
        mx = fmaxf(mx, sc);
      }
    if (__any(mx > m[r] + 8.f)) {
      mx = fmaxf(mx, shx(mx, 16));
      mx = fmaxf(mx, shx(mx, 32));
      const float mn = fmaxf(m[r], mx);
      const float alpha = __builtin_amdgcn_exp2f(m[r] - mn);
      ls[r] *= alpha;
      m[r] = mn;
#pragma unroll
      for (int dt = 0; dt < 4; ++dt) O[r][dt] *= alpha;
    }
    float sum = 0.f;
#pragma unroll
    for (int tl = 0; tl < 2; ++tl)
#pragma unroll
      for (int i = 0; i < 4; ++i) {
        const float pv = __builtin_amdgcn_exp2f(sv[tl][i] - m[r]);
        sv[tl][i] = pv;
        sum += pv;
      }
    ls[r] += sum;
    Pb[r] = packp(sv[0], sv[1]);
  }
  pv_tiles(Vc, Pb, O);
}

template <int MODE>
__device__ __forceinline__ void att_one(int e, const bf16x8 (&Kc)[2][2], const bf16x8 (&Vc)[4], int t, u64 mymask, const bf16x8* qlds,
                                        int lane, int fr, int fq, const float (&slope)[4], float (&m)[4], float (&ls)[4],
                                        f32x4 (&O)[4][4]) {
  const int d0 = t - (e * 32 + fq * 8);
  bool selq = true;
  if (MODE == 1) {
    const int j = e >> 1;
    const int sb = (int)((mymask >> (j & 63)) & 1ull);
    selq = __shfl(sb, fr + 16 * (j >> 6), 64) != 0;
  }
  att_step<MODE, true>(Kc, Vc, d0, selq, qlds, lane, slope, m, ls, O);
}
template <int MODE>
__device__ __forceinline__ void att_loop(int ns, const u32* list, const u16* __restrict__ Kb, const u16* __restrict__ Vb, int t,
                                         int t0, u64 mymask, const bf16x8* qlds, int lane, int fr, int fq, const float (&slope)[4],
                                         float (&m)[4], float (&ls)[4], f32x4 (&O)[4][4]) {
  if (ns <= 0) return;
  const int krow0 = (fr >> 2) * 8 + (fr & 3);
  bf16x8 Ka[2][2];
  int ea = __builtin_amdgcn_readfirstlane((int)list[ns - 1]);
  ld_kfp(Kb + (size_t)ea * 2048, Ka, krow0, fq);
#pragma unroll 1
  for (int s = ns - 1; s >= 0; --s) {
    bf16x8 Va[4], Kq[2][2];
    ld_vfp(Vb + (size_t)(ea >> 1) * 4096 + (ea & 1) * 32, Va, fr, fq);
    int eb = ea;
    if (s >= 1) {
      eb = __builtin_amdgcn_readfirstlane((int)list[s - 1]);
      ld_kfp(Kb + (size_t)eb * 2048, Kq, krow0, fq);
    }
    att_one<MODE>(ea, Ka, Va, t, mymask, qlds, lane, fr, fq, slope, m, ls, O);
    if (s >= 1) {
#pragma unroll
      for (int tl = 0; tl < 2; ++tl)
#pragma unroll
        for (int ks = 0; ks < 2; ++ks) Ka[tl][ks] = Kq[tl][ks];
    }
    ea = eb;
  }
}

__device__ __forceinline__ void nsa_task(const P& p, int l, int b, int qt, int g, u32* keys, float* xch, int wid) {
  int lane = tidx() & 63, fr = lane & 15, fq = lane >> 4;
#define LAUNDER() asm volatile("" : "+v"(fr), "+v"(fq), "+v"(lane))
  const int t0 = qt * 16, t = t0 + fr, cur = t0 >> 6;
  const size_t tok = (size_t)b * T + t;
  unsigned char* big = p.ws + O_BIG;
  const u16* QN = (const u16*)(big + B_QN);
  const float* GS = (const float*)(big + B_GS);
  float* ONSA = (float*)(p.ws + O_Y);
  u16* CAT = (u16*)(p.ws + O_HB);
  u32* krow = keys + fr * KEYSTR;
  float ssq = 0.f;
  f32x4 O[4][4];
  {
    const int bg = b * 2 + g;
    bf16x8 Qf[4][2];
    float slope[4];
#pragma unroll
    for (int r = 0; r < 4; ++r) {
#pragma unroll
      for (int ks = 0; ks < 2; ++ks) Qf[r][ks] = ld8(QN + tok * 512 + (g * 4 + r) * 64 + ks * 32 + fq * 8);
      slope[r] = exp2f(-(float)(g * 4 + r + 1)) * 1.4426950408889634f;
    }
    const float* gsp = GS + tok * 24 + g * 12;
    float* onp = ONSA + tok * 512 + g * 256 + fq * 4;
    const u16* Kc = (const u16*)(p.ws + O_SMALL + S_KCC) + (size_t)bg * 65536;
    const u16* Vc = (const u16*)(p.ws + O_SMALL + S_VCT) + (size_t)bg * 65536;
    float m[4], ls[4];
    const int nlast = (t0 + 15 - 31) >> 4;
    const int nit = nlast >= 0 ? (nlast >> 5) + 1 : 0;
    LAUNDER();
#pragma unroll
    for (int r = 0; r < 4; ++r) { m[r] = NEG; ls[r] = 0.f; }
    {
      const int krow0 = (fr >> 2) * 8 + (fr & 3);
      bf16x8 Kf[2][2];
      if (nit > 0) ld_kfp(Kc, Kf, krow0, fq);
#pragma unroll 1
      for (int it = 0; it < nit; ++it) {
        bf16x8 Kn[2][2];
        const bool more = (it + 1 < nit);
        if (more) ld_kfp(Kc + (size_t)(it + 1) * 2048, Kn, krow0, fq);
        const int n0 = it * 32 + fq * 8;
        float fd[2][4];
#pragma unroll
        for (int tl = 0; tl < 2; ++tl)
#pragma unroll
          for (int i = 0; i < 4; ++i) {
            const int n = n0 + tl * 4 + i;
            fd[tl][i] = (16 * n + 31 <= t) ? (float)t - (16.f * (float)n + 15.5f) : __builtin_inff();
          }
#pragma unroll
        for (int r = 0; r < 4; ++r) {
          f32x4 sv[2];
          qk_r(Kf, Qf[r], sv[0], sv[1]);
          float mx = m[r];
#pragma unroll
          for (int tl = 0; tl < 2; ++tl)
#pragma unroll
            for (int i = 0; i < 4; ++i) {
              const float sc = __builtin_fmaf(-slope[r], fd[tl][i], sv[tl][i]);
              sv[tl][i] = sc;
              mx = fmaxf(mx, sc);
            }
          float sum = ls[r] * __builtin_amdgcn_exp2f(m[r] - mx);
#pragma unroll
          for (int tl = 0; tl < 2; ++tl)
#pragma unroll
            for (int i = 0; i < 4; ++i) sum += __builtin_amdgcn_exp2f(sv[tl][i] - mx);
          ls[r] = sum;
          m[r] = mx;
        }
        if (more) {
#pragma unroll
          for (int tl = 0; tl < 2; ++tl)
#pragma unroll
            for (int ks = 0; ks < 2; ++ks) Kf[tl][ks] = Kn[tl][ks];
        }
      }
    }
#pragma unroll
    for (int r = 0; r < 4; ++r) {
      float mr = fmaxf(m[r], shx(m[r], 16));
      mr = fmaxf(mr, shx(mr, 32));
      float lt = ls[r] * __builtin_amdgcn_exp2f(m[r] - mr);
      lt += shx(lt, 16);
      lt += shx(lt, 32);
      m[r] = mr + __builtin_amdgcn_logf(fmaxf(lt, 1e-30f));
    }
    LAUNDER();
#pragma unroll 1
    for (int i = 0; i < 16; ++i) {
      const u32 j = fq * 64 + i * 4;
      u32x4 kv = {255u - j, 254u - j, 253u - j, 252u - j};
      *reinterpret_cast<u32x4*>(krow + j) = kv;
    }
#pragma unroll
    for (int r = 0; r < 4; ++r)
#pragma unroll
      for (int dt = 0; dt < 4; ++dt) O[r][dt] = f32x4{0.f, 0.f, 0.f, 0.f};
    LAUNDER();
    {
      float carry = 0.f;
      const int krow0 = (fr >> 2) * 8 + (fr & 3);
      bf16x8 Kf[2][2];
      if (nit > 0) ld_kfp(Kc, Kf, krow0, fq);
#pragma unroll 1
      for (int it = 0; it < nit; ++it) {
        bf16x8 Vf[4], Kn[2][2];
        ld_vfp(Vc + (size_t)(it >> 1) * 4096 + (it & 1) * 32, Vf, fr, fq);
        const bool more = (it + 1 < nit);
        if (more) ld_kfp(Kc + (size_t)(it + 1) * 2048, Kn, krow0, fq);
        const int n0 = it * 32 + fq * 8;
        bf16x8 Pb[4];
        f32x4 ps[2] = {f32x4{0.f, 0.f, 0.f, 0.f}, f32x4{0.f, 0.f, 0.f, 0.f}};
        float fd[2][4];
#pragma unroll
        for (int tl = 0; tl < 2; ++tl)
#pragma unroll
          for (int i = 0; i < 4; ++i) {
            const int n = n0 + tl * 4 + i;
            fd[tl][i] = (16 * n + 31 <= t) ? (float)t - (16.f * (float)n + 15.5f) : __builtin_inff();
          }
#pragma unroll
        for (int r = 0; r < 4; ++r) {
          f32x4 sv[2];
          qk_r(Kf, Qf[r], sv[0], sv[1]);
#pragma unroll
          for (int tl = 0; tl < 2; ++tl) {
#pragma unroll
            for (int i = 0; i < 4; ++i)
              sv[tl][i] = __builtin_amdgcn_exp2f(__builtin_fmaf(-slope[r], fd[tl][i], sv[tl][i]) - m[r]);
            ps[tl] += sv[tl];
          }
          Pb[r] = packp(sv[0], sv[1]);
        }
        {
          const float c1 = 0.5f * ps[1][3];
          const float rcv = __shfl(c1, (lane + 48) & 63, 64);
          const float add = fq > 0 ? rcv : carry;
          carry = rcv;
          const float a0 = ps[0][0] + ps[0][1] + ps[0][2] + 0.5f * ps[0][3] + add;
          const float a1 = ps[1][0] + ps[1][1] + ps[1][2] + 0.5f * ps[1][3] + 0.5f * ps[0][3];
          const int j0 = it * 8 + fq * 2;
          u32x2 kk = {(__float_as_uint(a0) & 0xFFFFFF00u) | (u32)(255 - j0), (__float_as_uint(a1) & 0xFFFFFF00u) | (u32)(254 - j0)};
          *reinterpret_cast<u32x2*>(krow + j0) = kk;
        }
        pv_tiles(Vf, Pb, O);
        if (more) {
#pragma unroll
          for (int tl = 0; tl < 2; ++tl)
#pragma unroll
            for (int ks = 0; ks < 2; ++ks) Kf[tl][ks] = Kn[tl][ks];
        }
      }
    }
    LAUNDER();
    {
#pragma unroll
      for (int r = 0; r < 4; ++r) {
        const float gt = gsp[r * 3 + 0];
#pragma unroll
        for (int dt = 0; dt < 4; ++dt) *reinterpret_cast<f32x4*>(onp + r * 64 + dt * 16) = O[r][dt] * gt;
      }
    }
    LAUNDER();
    {
      const u32 F = 0x461C4000u;
      if (fq == 0) krow[0] = F | 255u;
      if (fq == (cur >> 6)) krow[cur] = F | (u32)(255 - cur);
      if (cur >= 1 && fq == ((cur - 1) >> 6)) krow[cur - 1] = F | (u32)(255 - (cur - 1));
    }
    __builtin_amdgcn_wave_barrier();
    u64 mymask = 0ull;
#pragma unroll 1
    for (int rd = 0; rd < 16; ++rd) {
      u32 mx = 0u;
      const u32x4* k4 = reinterpret_cast<const u32x4*>(krow + fq * 64);
#pragma unroll
      for (int i = 0; i < 16; ++i) {
        u32x4 v = k4[i];
        u32 a = v.x > v.y ? v.x : v.y;
        u32 c = v.z > v.w ? v.z : v.w;
        a = a > c ? a : c;
        mx = mx > a ? mx : a;
      }
      u32 o1 = (u32)__shfl_xor((int)mx, 16, 64);
      mx = mx > o1 ? mx : o1;
      u32 o2 = (u32)__shfl_xor((int)mx, 32, 64);
      mx = mx > o2 ? mx : o2;
      const int jw = 255 - (int)(mx & 255u);
      if ((jw >> 6) == fq) {
        krow[jw] = 0u;
        mymask |= 1ull << (jw & 63);
      }
      __builtin_amdgcn_wave_barrier();
    }
    u32 ulo = (u32)mymask, uhi = (u32)(mymask >> 32);
#pragma unroll
    for (int o = 1; o <= 8; o <<= 1) {
      ulo |= (u32)__shfl_xor((int)ulo, o, 64);
      uhi |= (u32)__shfl_xor((int)uhi, o, 64);
    }
    bf16x8* qlds = reinterpret_cast<bf16x8*>(keys);
    u32* list = keys + 2048;
    __builtin_amdgcn_wave_barrier();
#pragma unroll
    for (int r = 0; r < 4; ++r)
#pragma unroll
      for (int ks = 0; ks < 2; ++ks) qlds[(r * 2 + ks) * 64 + lane] = Qf[r][ks];
    int ns = 0;
    const int nhc = ((t0 + 15 - 64 * cur) >> 5) + 1;
#pragma unroll 1
    for (int part = 0; part < 4; ++part) {
      u64 um = ((u64)(u32)__builtin_amdgcn_readlane((int)uhi, part * 16) << 32) |
               (u64)(u32)__builtin_amdgcn_readlane((int)ulo, part * 16);
      while (um) {
        const int bit = __builtin_ctzll(um);
        um &= um - 1;
        const int j = part * 64 + bit;
        if (j > cur) break;
        const int nh = (j == cur) ? nhc : 2;
        if (lane == 0) { list[ns] = (u32)(2 * j); if (nh > 1) list[ns + 1] = (u32)(2 * j + 1); }
        ns += nh;
      }
    }
    __builtin_amdgcn_wave_barrier();
    LAUNDER();
    const u16* KS = (const u16*)(big + B_KS) + (size_t)bg * T * 64;
    const u16* VST = (const u16*)(big + B_VST) + (size_t)bg * 256 * 4096;
#pragma unroll
    for (int r = 0; r < 4; ++r) {
      m[r] = NEG; ls[r] = 0.f;
#pragma unroll
      for (int dt = 0; dt < 4; ++dt) O[r][dt] = f32x4{0.f, 0.f, 0.f, 0.f};
    }
    att_loop<1>(ns, list, KS, VST, t, t0, mymask, qlds, lane, fr, fq, slope, m, ls, O);
    LAUNDER();
#pragma unroll
    for (int r = 0; r < 4; ++r) {
      float lt = ls[r] + shx(ls[r], 16);
      lt += shx(lt, 32);
      const float sc = gsp[r * 3 + 1] / fmaxf(lt, 1e-30f);
#pragma unroll
      for (int dt = 0; dt < 4; ++dt) {
        f32x4* ptr = reinterpret_cast<f32x4*>(onp + r * 64 + dt * 16);
        *ptr = *ptr + O[r][dt] * sc;
      }
    }
    LAUNDER();
    const u16* KW = (const u16*)(big + B_KW) + (size_t)bg * T * 64;
    const u16* VWT = (const u16*)(big + B_VWT) + (size_t)bg * 256 * 4096;
#pragma unroll
    for (int r = 0; r < 4; ++r) {
      m[r] = NEG; ls[r] = 0.f;
#pragma unroll
      for (int dt = 0; dt < 4; ++dt) O[r][dt] = f32x4{0.f, 0.f, 0.f, 0.f};
    }
    {
      const int lo = t0 - 511 > 0 ? t0 - 511 : 0;
      const int e0 = (lo >> 6) * 2;
      const int nsw = cur * 2 + nhc - e0;
      __builtin_amdgcn_wave_barrier();
#pragma unroll 1
      for (int i = lane; i < nsw; i += 64) list[i] = (u32)(e0 + i);
      __builtin_amdgcn_wave_barrier();
      att_loop<2>(nsw, list, KW, VWT, t, t0, 0ull, qlds, lane, fr, fq, slope, m, ls, O);
    }
    LAUNDER();
#pragma unroll
    for (int r = 0; r < 4; ++r) {
      float lt = ls[r] + shx(ls[r], 16);
      lt += shx(lt, 32);
      const float sc = gsp[r * 3 + 2] / fmaxf(lt, 1e-30f);
#pragma unroll
      for (int dt = 0; dt < 4; ++dt) {
        f32x4* ptr = reinterpret_cast<f32x4*>(onp + r * 64 + dt * 16);
        f32x4 v = *ptr + O[r][dt] * sc;
        ssq += v[0] * v[0] + v[1] * v[1] + v[2] * v[2] + v[3] * v[3];
        O[r][dt] = v;
      }
    }
  }
  LAUNDER();
  ssq += shx(ssq, 16);
  ssq += shx(ssq, 32);
  if (fq == 0) xch[wid * 16 + fr] = ssq;
  __syncthreads();
  const float tot = ssq + xch[(wid ^ 1) * 16 + fr];
  const float rinv = rsqrtf(tot * (1.f / 512.f) + EPS);
  const float* gn = p.nsa_out_g + (size_t)l * 512 + g * 256 + fq * 8;
  u16* cp = CAT + tok * 1024 + g * 256 + fq * 8;
#pragma unroll
  for (int r = 0; r < 4; ++r)
#pragma unroll
    for (int pp = 0; pp < 2; ++pp) {
      f32x4 g0 = *reinterpret_cast<const f32x4*>(gn + r * 64 + pp * 32), g1 = *reinterpret_cast<const f32x4*>(gn + r * 64 + pp * 32 + 4);
      st8bf_n(cp + r * 64 + pp * 32, O[r][2 * pp] * g0 * rinv, O[r][2 * pp + 1] * g1 * rinv);
    }
}
#undef LAUNDER
__device__ __forceinline__ void ret_kv_block(const P& p, int first, int step, unsigned char* smem) {
  const int tid = tidx(), lane = tid & 63, wid = __builtin_amdgcn_readfirstlane(tid >> 6), fr = lane & 15, fq = lane >> 4;
  u32x4 rg[8];
  auto gload = [&](int ch) {
    const u16* Kt = (const u16*)(p.ws + O_BIG + B_KRT) + (size_t)ch * 16384;
    const u16* Vt = (const u16*)(p.ws + O_BIG + B_VRT) + (size_t)ch * 16384;
#pragma unroll
    for (int i = 0; i < 8; ++i) {
      const int slot = wid * 8 + i;
      const u16* src = (slot < 32 ? Kt : Vt) + (((slot & 31) >> 2) * 16 + fr) * 128 + (slot & 3) * 32 + fq * 8;
      rg[i] = *reinterpret_cast<const u32x4*>(src);
    }
  };
  if (first < 1024) gload(first);
  for (int ch = first; ch < 1024; ch += step) {
    __syncthreads();
#pragma unroll
    for (int i = 0; i < 8; ++i) *reinterpret_cast<u32x4*>(smem + (wid * 8 + i) * 1024 + lane * 16) = rg[i];
    __syncthreads();
    if (ch + step < 1024) gload(ch + step);
    float* KVF = (float*)(p.ws + O_Y) + (size_t)ch * 16384;
    const unsigned char* lb = smem + lane * 16;
    bf16x8 Af[4];
#pragma unroll
    for (int ks = 0; ks < 4; ++ks) Af[ks] = *reinterpret_cast<const bf16x8*>(lb + (wid * 4 + ks) * 1024);
#pragma unroll
    for (int et = 0; et < 8; ++et) {
      f32x4 acc = {0.f, 0.f, 0.f, 0.f};
#pragma unroll
      for (int ks = 0; ks < 4; ++ks) acc = mfma16(Af[ks], *reinterpret_cast<const bf16x8*>(lb + (32 + et * 4 + ks) * 1024), acc);
      *reinterpret_cast<f32x4*>(KVF + (et * 16 + fr) * 128 + wid * 16 + fq * 4) = acc;
    }
  }
}
__device__ __forceinline__ void ret_scan(const P& p) {
  const float* KVF = (const float*)(p.ws + O_Y);
  u16* ST = (u16*)(p.ws + O_Y + 64 * MiB);
  const int gt = bidx() * 512 + tidx(), nt = gdim() * 512;
  for (int idx = gt; idx < 8 * 4096; idx += nt) {
    const int bh = idx >> 12, ed = (idx & 4095) * 4, h = bh & 3;
    const float cd = exp2f(128.f * ret_lg(h));
    f32x4 st = {0.f, 0.f, 0.f, 0.f};
    const size_t base = (size_t)bh * 128 * 16384 + ed;
#pragma unroll 4
    for (int c = 0; c < 128; ++c) {
      st4bf(ST + base + (size_t)c * 16384, st);
      st = st * cd + *reinterpret_cast<const f32x4*>(KVF + base + (size_t)c * 16384);
    }
  }
}
__device__ __forceinline__ void ret_out_block(const P& p, int l, int first, int step, unsigned char* smem) {
  const int tid = tidx(), lane = tid & 63, wid = __builtin_amdgcn_readfirstlane(tid >> 6), fr = lane & 15, fq = lane >> 4;
  unsigned char* big = p.ws + O_BIG;
  const u16* QR = (const u16*)(big + B_QR);
  const u16* KR = (const u16*)(big + B_KR);
  const u16* GR = (const u16*)(big + B_GR);
  u16* CAT = (u16*)(p.ws + O_HB);
  const int krow0 = (fr >> 2) * 8 + (fr & 3);
  u32x4 rg[12];
  auto gload = [&](int ch) {
    const int c = ch & 127, bh = ch >> 7, h = bh & 3, b = bh >> 2;
    const size_t tokc = (size_t)b * T + (size_t)c * 128;
    const u16* Vt = (const u16*)(big + B_VRT) + (size_t)ch * 16384;
    const u16* ST = (const u16*)(p.ws + O_Y + 64 * MiB) + (size_t)ch * 16384;
#pragma unroll
    for (int i = 0; i < 12; ++i) {
      const int slot = wid * 12 + i;
      const u16* src;
      if (slot < 32) {
        const int u = slot >> 3, tl = (slot >> 2) & 1, ks = slot & 3;
        src = KR + (tokc + u * 32 + krow0 + tl * 4) * 512 + h * 128 + ks * 32 + fq * 8;
      } else if (slot < 64) {
        const int et = (slot - 32) >> 2, u = slot & 3;
        src = Vt + ((et >> 1) * 32 + (fr >> 2) * 8 + (et & 1) * 4 + (fr & 3)) * 128 + u * 32 + fq * 8;
      } else {
        const int et = (slot - 64) >> 2, ks = slot & 3;
        src = ST + ((et >> 1) * 32 + (fr >> 2) * 8 + (et & 1) * 4 + (fr & 3)) * 128 + ks * 32 + fq * 8;
      }
      rg[i] = *reinterpret_cast<const u32x4*>(src);
    }
  };
  if (first < 1024) gload(first);
  for (int ch = first; ch < 1024; ch += step) {
    const int c = ch & 127, bh = ch >> 7, h = bh & 3, b = bh >> 2;
    __syncthreads();
#pragma unroll
    for (int i = 0; i < 12; ++i) *reinterpret_cast<u32x4*>(smem + (wid * 12 + i) * 1024 + lane * 16) = rg[i];
    __syncthreads();
    if (ch + step < 1024) gload(ch + step);
    const size_t tokc = (size_t)b * T + (size_t)c * 128;
    const int n = wid * 16 + fr;
    const size_t tok = tokc + n;
    const float lg = ret_lg(h);
    bf16x8 Qf[4];
#pragma unroll
    for (int ks = 0; ks < 4; ++ks) Qf[ks] = ld8(QR + tok * 512 + h * 128 + ks * 32 + fq * 8);
    f32x4 O[8];
#pragma unroll
    for (int et = 0; et < 8; ++et) O[et] = f32x4{0.f, 0.f, 0.f, 0.f};
    const unsigned char* lb = smem + lane * 16;
    const int nu = (wid >> 1) + 1;
#pragma unroll 1
    for (int u = 0; u < nu; ++u) {
      f32x4 S[2];
#pragma unroll
      for (int tl = 0; tl < 2; ++tl) {
        f32x4 z = {0.f, 0.f, 0.f, 0.f};
#pragma unroll
        for (int ks = 0; ks < 4; ++ks) z = mfma16(*reinterpret_cast<const bf16x8*>(lb + (u * 8 + tl * 4 + ks) * 1024), Qf[ks], z);
#pragma unroll
        for (int i = 0; i < 4; ++i) {
          const int diff = n - (u * 32 + fq * 8 + tl * 4 + i);
          z[i] = diff >= 0 ? z[i] * __builtin_amdgcn_exp2f((float)diff * lg) : 0.f;
        }
        S[tl] = z;
      }
      bf16x8 Pb = packp(S[0], S[1]);
#pragma unroll
      for (int et = 0; et < 8; ++et) O[et] = mfma16(*reinterpret_cast<const bf16x8*>(lb + (32 + et * 4 + u) * 1024), Pb, O[et]);
    }
    const float qd = __builtin_amdgcn_exp2f((float)(n + 1) * lg);
    float s1 = 0.f;
#pragma unroll
    for (int et = 0; et < 8; ++et) {
      f32x4 x = {0.f, 0.f, 0.f, 0.f};
#pragma unroll
      for (int ks = 0; ks < 4; ++ks) x = mfma16(*reinterpret_cast<const bf16x8*>(lb + (64 + et * 4 + ks) * 1024), Qf[ks], x);
      O[et] += x * qd;
      s1 += O[et][0] + O[et][1] + O[et][2] + O[et][3];
    }
    s1 += shx(s1, 16);
    s1 += shx(s1, 32);
    const float mu = s1 * (1.f / 128.f);
    float s2 = 0.f;
#pragma unroll
    for (int et = 0; et < 8; ++et) {
      O[et] -= mu;
      s2 += O[et][0] * O[et][0] + O[et][1] * O[et][1] + O[et][2] * O[et][2] + O[et][3] * O[et][3];
    }
    s2 += shx(s2, 16);
    s2 += shx(s2, 32);
    const float rinv = rsqrtf(s2 * (1.f / 128.f) + EPS);
    const float* gn = p.ret_gn_g + (size_t)l * 512 + h * 128;
#pragma unroll
    for (int pp = 0; pp < 4; ++pp) {
      const int e = pp * 32 + fq * 8;
      f32x4 g0 = *reinterpret_cast<const f32x4*>(gn + e), g1 = *reinterpret_cast<const f32x4*>(gn + e + 4);
      u32x4 gr = *reinterpret_cast<const u32x4*>(GR + tok * 512 + h * 128 + e);
      f32x4 sg0, sg1;
      bf8_to_f32(gr, sg0, sg1);
      st8bf_n(CAT + tok * 1024 + 512 + h * 128 + e, O[2 * pp] * rinv * g0 * sg0, O[2 * pp + 1] * rinv * g1 * sg1);
    }
  }
}

__device__ __forceinline__ void xattn_block(const P& p, int id, unsigned char* smem) {
  const int tid = tidx(), lane = tid & 63, wid = __builtin_amdgcn_readfirstlane(tid >> 6), fr = lane & 15, fq = lane >> 4;
  const int qb = id & 127, hd = (id >> 7) & 3, b = id >> 9;
  const u16* QX = (const u16*)(p.ws + O_BIG);
  u16* OX = (u16*)(p.ws + O_BIG + 64 * MiB);
  const u16* KM = (const u16*)(p.ws + O_SMALL + S_KMEM) + (size_t)b * 256 * 1024 + hd * 256;
  const u16* VM = (const u16*)(p.ws + O_SMALL + S_VMEMT) + ((size_t)b * 1024 + hd * 256) * 256;
  const size_t tok = (size_t)b * T + qb * 128 + wid * 16 + fr;
  bf16x8 Qf[8];
#pragma unroll
  for (int ks = 0; ks < 8; ++ks) Qf[ks] = ld8(QX + tok * 1024 + hd * 256 + ks * 32 + fq * 8);
  f32x4 O[16];
#pragma unroll
  for (int et = 0; et < 16; ++et) O[et] = f32x4{0.f, 0.f, 0.f, 0.f};
  float m = NEG, ls = 0.f;
  const int krow0 = (fr >> 2) * 8 + (fr & 3);
  u32x4 rk[2], rv[2];
  auto gload = [&](int c) {
#pragma unroll
    for (int i = 0; i < 2; ++i) {
      const int slot = wid * 2 + i, tl = slot >> 3, ks = slot & 7;
      rk[i] = *reinterpret_cast<const u32x4*>(KM + (size_t)(c * 32 + krow0 + tl * 4) * 1024 + ks * 32 + fq * 8);
      rv[i] = *reinterpret_cast<const u32x4*>(VM + (size_t)((slot >> 1) * 32 + (fr >> 2) * 8 + (slot & 1) * 4 + (fr & 3)) * 256 + c * 32 + fq * 8);
    }
  };
  auto swrite = [&](int buf) {
#pragma unroll
    for (int i = 0; i < 2; ++i) {
      const int slot = wid * 2 + i;
      *reinterpret_cast<u32x4*>(smem + buf * 32768 + slot * 1024 + lane * 16) = rk[i];
      *reinterpret_cast<u32x4*>(smem + buf * 32768 + 16384 + slot * 1024 + lane * 16) = rv[i];
    }
  };
  __syncthreads();
  gload(0);
  swrite(0);
  __syncthreads();
#pragma unroll 1
  for (int c = 0; c < 8; ++c) {
    const int buf = c & 1;
    if (c + 1 < 8) gload(c + 1);
    const unsigned char* kb = smem + buf * 32768 + lane * 16;
    const unsigned char* vb = kb + 16384;
    f32x4 S[2];
#pragma unroll
    for (int tl = 0; tl < 2; ++tl) {
      f32x4 z = {0.f, 0.f, 0.f, 0.f};
#pragma unroll
      for (int ks = 0; ks < 8; ++ks) z = mfma16(*reinterpret_cast<const bf16x8*>(kb + (tl * 8 + ks) * 1024), Qf[ks], z);
      S[tl] = z;
    }
    float mx = fmaxf(fmaxf(fmaxf(S[0][0], S[0][1]), fmaxf(S[0][2], S[0][3])), fmaxf(fmaxf(S[1][0], S[1][1]), fmaxf(S[1][2], S[1][3])));
    mx = fmaxf(mx, shx(mx, 16));
    mx = fmaxf(mx, shx(mx, 32));
    const float mn = fmaxf(m, mx);
    const float alpha = __expf(m - mn);
    float sum = 0.f;
#pragma unroll
    for (int tl = 0; tl < 2; ++tl)
#pragma unroll
      for (int i = 0; i < 4; ++i) {
        float e = __expf(S[tl][i] - mn);
        S[tl][i] = e;
        sum += e;
      }
    ls = ls * alpha + sum;
    m = mn;
    bf16x8 Pb = packp(S[0], S[1]);
#pragma unroll
    for (int et = 0; et < 16; ++et) {
      O[et] *= alpha;
      O[et] = mfma16(*reinterpret_cast<const bf16x8*>(vb + et * 1024), Pb, O[et]);
    }
    if (c + 1 < 8) swrite(buf ^ 1);
    __syncthreads();
  }
  ls += shx(ls, 16);
  ls += shx(ls, 32);
  const float inv = 1.f / ls;
#pragma unroll
  for (int pp = 0; pp < 8; ++pp) st8bf_n(OX + tok * 1024 + hd * 256 + pp * 32 + fq * 8, O[2 * pp] * inv, O[2 * pp + 1] * inv);
}

#define XB_TMO      128
#define XB_XCNT(j)  (256  + 64 * (j))
#define XB_XSUB(j)  (1280 + 64 * (j))
#define XB_XGEN(j)  (2304 + 64 * (j))
#define XB_TOP      3328
#define XB_TOPGEN   3392
#define XCD_BAR_WORDS 3456
#define XB_SPIN_CAP (1u << 18)
#define LAS __attribute__((address_space(3)))

__device__ __forceinline__ unsigned xb_ld(unsigned* p)              { return __hip_atomic_load(p, __ATOMIC_RELAXED, __HIP_MEMORY_SCOPE_AGENT); }
__device__ __forceinline__ unsigned xb_add(unsigned* p, unsigned v) { return __hip_atomic_fetch_add(p, v, __ATOMIC_RELAXED, __HIP_MEMORY_SCOPE_AGENT); }
__device__ __forceinline__ unsigned xb_xcc_id() { return (unsigned)__builtin_amdgcn_s_getreg((3 << 11) | 20) & 0xFu; }
#define XB_SPIN(cond, bar) do { unsigned _sp = 0; while (cond) { __builtin_amdgcn_s_sleep(1); \
    if ((++_sp & 255u) == 0u) { if (xb_ld(&(bar)[XB_TMO])) break; if (_sp > XB_SPIN_CAP) { atomicAdd(&(bar)[XB_TMO], 1u); break; } } } } while (0)

struct XcdBarrier {
    unsigned* bar; unsigned x;
    volatile LAS unsigned* st;
};

__device__ __forceinline__ XcdBarrier xcd_barrier_post(unsigned* bar, volatile LAS unsigned* st) {
    XcdBarrier b; b.bar = bar; b.x = xb_xcc_id(); b.st = st;
    if (threadIdx.x == 0) (void)xb_add(&bar[XB_XCNT(b.x)], 1u);
    return b;
}
__device__ __forceinline__ void xcd_barrier_complete(unsigned* bar, unsigned x, unsigned& nloc, unsigned& nx) {
    const unsigned G = gridDim.x * gridDim.y * gridDim.z;
    unsigned sum, cnt, mine, sp = 0u;
    for (;;) {
        sum = 0u; cnt = 0u; mine = 0u;
#pragma unroll
        for (unsigned j = 0; j < 16; ++j) { const unsigned c = xb_ld(&bar[XB_XCNT(j)]); sum += c; cnt += (c > 0u) ? 1u : 0u; mine = (j == x) ? c : mine; }
        if (sum == G) break;
        __builtin_amdgcn_s_sleep(1);
        if ((++sp & 255u) == 0u) { if (xb_ld(&bar[XB_TMO])) break; if (sp > XB_SPIN_CAP) { atomicAdd(&bar[XB_TMO], 1u); break; } }
    }
    nloc = mine > 0u ? mine : 1u; nx = cnt > 0u ? cnt : 1u;
}

__device__ __forceinline__ void xcd_barrier(const XcdBarrier& b) {
    asm volatile("s_waitcnt vmcnt(0)" ::: "memory");
    __syncthreads();
    if (threadIdx.x == 0) {
        unsigned* bar = b.bar;
        __builtin_amdgcn_s_waitcnt(0);
        unsigned nloc = b.st[0], nx = b.st[1];
        if (nloc == 0u) { xcd_barrier_complete(bar, b.x, nloc, nx); b.st[0] = nloc; b.st[1] = nx; }
        const unsigned old = xb_add(&bar[XB_XSUB(b.x)], 1u);
        const unsigned gen = old / nloc;
        if (old + 1u == (gen + 1u) * nloc) {
            __builtin_amdgcn_fence(__ATOMIC_RELEASE, "agent");
            asm volatile("s_waitcnt vmcnt(0)" ::: "memory");
            const unsigned og = xb_add(&bar[XB_TOP], 1u);
            const unsigned tg = og / nx;
            if (og + 1u == (tg + 1u) * nx) xb_add(&bar[XB_TOPGEN], 1u);
            else XB_SPIN(xb_ld(&bar[XB_TOPGEN]) == tg, bar);
            __builtin_amdgcn_fence(__ATOMIC_ACQUIRE, "agent");
            xb_add(&bar[XB_XGEN(b.x)], 1u);
            asm volatile("s_waitcnt vmcnt(0)" ::: "memory");
        } else {
            XB_SPIN(xb_ld(&bar[XB_XGEN(b.x)]) == gen, bar);
            __builtin_amdgcn_fence(__ATOMIC_ACQUIRE, "agent");
            asm volatile("s_waitcnt vmcnt(0)" ::: "memory");
        }
    }
    __syncthreads();
}

__device__ __forceinline__ void run_phase(const P& p, int ph, unsigned char* smem) {
  unsigned char* ws = p.ws;
  u16* sm = reinterpret_cast<u16*>(smem);
  u16* HB = (u16*)(ws + O_HB);
  float* Y = (float*)(ws + O_Y);
  unsigned char* big = ws + O_BIG;
  u16* ACT = (u16*)big;
  const int wid = __builtin_amdgcn_readfirstlane(tidx() >> 6);
  const int gw = bidx() * 8 + wid, nw = gdim() * 8;
  const int l = ph == 0 ? 0 : (ph - 1) >> 4;
  const int sub = ph == 0 ? -1 : (ph - 1) & 15;
  const u16* memn = (const u16*)(ws + O_SMALL + S_MEMN) + (size_t)l * 512 * 1024;

  {
    u16* XB = (u16*)((unsigned char*)p.out + 64 * MiB);
    int njobs = 0;
    if (ph == 0) njobs = 3;
    else if (sub == 2 || sub == 8 || sub == 12 || sub == 15) njobs = 1;
    for (int jb = 0; jb < njobs; ++jb) {
      const float *xin_f = nullptr, *gpost = nullptr, *gpre = nullptr;
      const u16 *xin_b = XB, *y = (const u16*)Y;
      u16 *xout_b = XB, *hb = HB;
      float *xout_f = nullptr, *xout_f2 = nullptr;
      float w = 1.f;
      int ntok = NTOK;
      if (ph == 0) {
        if (jb == 0) { xin_f = p.x; xin_b = nullptr; y = nullptr; gpre = p.ffn1_pre_g; }
        else {
          xin_f = p.mem; xin_b = nullptr; y = nullptr; xout_b = nullptr; gpre = p.xa_mem_g + (jb - 1) * 1024;
          hb = (u16*)(ws + O_SMALL + S_MEMN) + (size_t)(jb - 1) * 512 * 1024; ntok = 512;
        }
      } else if (sub == 2) { gpost = p.ffn1_post_g + l * 1024; w = 0.5f; gpre = p.mix_pre_g + l * 1024; }
      else if (sub == 8) { gpost = p.mix_post_g + l * 1024; gpre = p.xa_pre_g + l * 1024; }
      else if (sub == 12) { gpost = p.xa_post_g + l * 1024; gpre = p.ffn2_pre_g + l * 1024; if (l == 1) xout_b = (u16*)(big + 176 * MiB); }
      else {
        gpost = p.ffn2_post_g + l * 1024; w = 0.5f;
        if (l == 0) gpre = p.ffn1_pre_g + 1024;
        else {
          gpre = nullptr; hb = nullptr; xout_b = nullptr; xin_b = (const u16*)(big + 176 * MiB); xout_f = p.out; xout_f2 = p.out;
        }
      }
      norm_phase(xin_f, xin_b, y, gpost, w, xout_b, xout_f, xout_f2, gpre, hb, ntok);
    }
  }
  if (ph == 0 || (sub == 15 && l == 0)) convert_layer(p, ph == 0 ? 0 : 1, smem);
  if (sub == 0 || sub == 13) {
    EpiSwiglu E{ACT};
    big_gemm(smem, HB, (const u16*)(ws + (sub == 0 ? W_GU1 : W_GU2)), NTOK, 5632, 1024, E);
  }
  if (sub == 1 || sub == 7 || sub == 11 || sub == 14) {
    const u16* A = ACT; const u16* Bt = (u16*)(ws + W_D1); int K = DFF;
    if (sub == 7) { A = HB; Bt = (u16*)(ws + W_OUT); K = 1024; }
    else if (sub == 11) { A = (const u16*)(big + 64 * MiB); Bt = (u16*)(ws + W_O); K = 1024; }
    else if (sub == 14) { Bt = (u16*)(ws + W_D2); }
    EpiY E{(u16*)Y, 1024};
    big_gemm(smem, A, Bt, NTOK, 1024, K, E);
  }
  if (sub == 9) {
    EpiQ E{(u16*)big, 0.0625f};
    big_gemm(smem, HB, (const u16*)(ws + W_Q), NTOK, 1024, 1024, E);
  }
  if (sub == 3) {
    EpiWin E{big};
    big_gemm(smem, HB, (const u16*)(ws + W_IN), NTOK, 3584, 1024, E);
  }
  if (sub == 4) {
#pragma unroll 1
    for (int kv = 0; kv < 2; ++kv) {
      EpiC1 E{(u16*)(ws + O_SMALL + S_HC) + (size_t)kv * 4096 * 256, reinterpret_cast<const float*>(ws + W_BIAS) + kv * 8 * 256};
      big_gemm(smem, (const u16*)(big + (kv == 0 ? B_KCR : B_VCR)), (const u16*)(ws + W_C1) + (size_t)kv * 256 * 2048, 4096, 256, 2048,
               E, 1024, kv * 16);
    }
    gemm_phase<EP_BF16>(p, 0, 1.f, ws + O_SMALL + S_KMEM, 1024, memn, 1024, (u16*)(ws + W_K), 1024, 512, 1024, 1024, sm, 64);
    gemm_phase<EP_VMEMT>(p, 0, 1.f, ws + O_SMALL + S_VMEMT, 0, memn, 1024, (u16*)(ws + W_V), 1024, 512, 1024, 1024, sm, 96);
    ret_kv_block(p, bidx(), gdim(), smem);
  }
  if (sub == 5) {
    gemm_phase<EP_C2K>(p, 0, 1.f, ws + O_SMALL + S_KCC, 64, (const u16*)(ws + O_SMALL + S_HC), 256, (u16*)(ws + W_C2), 256,
                       4096, 128, 256, sm, 0);
    gemm_phase<EP_C2V>(p, 0, 1.f, ws + O_SMALL + S_VCT, 64, (const u16*)(ws + O_SMALL + S_HC) + (size_t)4096 * 256, 256,
                       (u16*)(ws + W_C2) + 128 * 256, 256, 4096, 128, 256, sm, 128);
    ret_scan(p);
  }
  if (sub == 6) {
    u32* keys = reinterpret_cast<u32*>(smem) + wid * 16 * KEYSTR;
    const int slots = gdim() * 4;
    for (int i = 0; i * slots < 2048; ++i) {
      const int Gs = gdim(), bs = (Gs & 7) == 0 ? (bidx() & 7) * (Gs >> 3) + (bidx() >> 3) : bidx();
      const int u = i * slots + bs * 4 + (wid >> 1);
      float* xch = reinterpret_cast<float*>(smem + SMEM_BYTES + 64) + (i & 1) * 128;
      if (u < 2048) {
        const int qt = u < 1024 ? 1023 - (u >> 1) : (u - 1024) >> 1;
        nsa_task(p, l, u & 1, qt, (wid & 1) ^ (i & 1), keys, xch, wid);
      } else {
        __syncthreads();
      }
    }
    ret_out_block(p, l, bidx(), gdim(), smem);
  }
  if (sub == 10)
    for (int id = bidx(); id < 1024; id += gdim()) xattn_block(p, id, smem);
}

__global__ void __launch_bounds__(512) hymba_mega(P p, int ph0, int ph1) {
  extern __shared__ __attribute__((aligned(16))) unsigned char smem[];
  cg::grid_group grid = cg::this_grid();
  volatile LAS unsigned* st = (volatile LAS unsigned*)(smem + SMEM_BYTES);
  if (threadIdx.x < 4) st[threadIdx.x] = 0u;
  __syncthreads();
  XcdBarrier xb = xcd_barrier_post((unsigned*)(p.ws + O_SMALL + S_BAR), st);
  for (int ph = ph0; ph < ph1; ++ph) {
#if defined(__HIP_DEVICE_COMPILE__)
    const __attribute__((address_space(4))) P* pp =
        (const __attribute__((address_space(4))) P*)__builtin_amdgcn_kernarg_segment_ptr();
    asm volatile("" : "+s"(pp));
    P q = *pp;
    run_phase(q, ph, smem);
#endif
    if (ph + 1 < ph1) {
      if (ph1 < 0) grid.sync();
      xcd_barrier(xb);
    }
  }
}

extern "C" void kernel_launch(void* const* d_in, const int* in_sizes, int n_in, void* d_out, int out_size, void* d_ws,
                              size_t ws_size, hipStream_t stream) {
  P p{};
  const float** pp = reinterpret_cast<const float**>(&p);
  for (int i = 0; i < 28; ++i) pp[i] = (const float*)d_in[i];
  p.out = (float*)d_out;
  p.ws = (unsigned char*)d_ws;
  if (ws_size < WS_NEED) {
    fprintf(stderr, "workspace too small: %zu < %zu\n", ws_size, (size_t)WS_NEED);
    return;
  }
  static int grid_blocks = 0;
  if (!grid_blocks) {
    hipFuncSetAttribute((const void*)hymba_mega, hipFuncAttributeMaxDynamicSharedMemorySize, SMEM_BYTES + 64 + 1024);
    int dev = 0, cus = 0, per = 0;
    hipGetDevice(&dev);
    hipDeviceGetAttribute(&cus, hipDeviceAttributeMultiprocessorCount, dev);
    hipOccupancyMaxActiveBlocksPerMultiprocessor(&per, hymba_mega, 512, SMEM_BYTES + 64 + 1024);
    if (per < 1) per = 1;
    grid_blocks = cus * per;
  }
  hipMemsetAsync((unsigned char*)d_ws + O_SMALL + S_BAR, 0, 16384, stream);
  int ph0 = 0, ph1 = NPH;
  void* args[] = {&p, &ph0, &ph1};
  hipError_t e = hipLaunchCooperativeKernel((void*)hymba_mega, dim3(grid_blocks), dim3(512), args, SMEM_BYTES + 64 + 1024, stream);
  if (e != hipSuccess) fprintf(stderr, "cooperative launch failed: %s (grid %d)\n", hipGetErrorString(e), grid_blocks);
}
```

```cpp
#include <hip/hip_runtime.h>
#include <hip/hip_cooperative_groups.h>
#include <stdint.h>
#include <stdio.h>
namespace cg = cooperative_groups;

typedef unsigned short u16;
typedef unsigned int u32;
typedef unsigned long long u64;
using bf16x8 = __attribute__((ext_vector_type(8))) short;
using f32x4 = __attribute__((ext_vector_type(4))) float;
using u32x4 = __attribute__((ext_vector_type(4))) unsigned int;
using u32x2 = __attribute__((ext_vector_type(2))) unsigned int;

constexpr int T = 16384, NTOK = 32768, DM = 1024, DFF = 2816;
constexpr int NPH = 33;
constexpr float EPS = 1e-6f;
constexpr float NEG = -1e30f;

constexpr size_t MiB = 1024ull * 1024ull;
constexpr size_t W_GU1 = 0;
constexpr size_t W_D1 = W_GU1 + 5632ull * 1024 * 2;
constexpr size_t W_IN = W_D1 + 1024ull * 2816 * 2;
constexpr size_t W_C1 = W_IN + 3584ull * 1024 * 2;
constexpr size_t W_C2 = W_C1 + 2ull * 256 * 2048 * 2;
constexpr size_t W_OUT = W_C2 + 2ull * 128 * 256 * 2;
constexpr size_t W_Q = W_OUT + 1024ull * 1024 * 2;
constexpr size_t W_K = W_Q + 1024ull * 1024 * 2;
constexpr size_t W_V = W_K + 1024ull * 1024 * 2;
constexpr size_t W_O = W_V + 1024ull * 1024 * 2;
constexpr size_t W_GU2 = W_O + 1024ull * 1024 * 2;
constexpr size_t W_D2 = W_GU2 + 5632ull * 1024 * 2;
constexpr size_t W_BIAS = W_D2 + 1024ull * 2816 * 2;
constexpr size_t W_END = W_BIAS + 16384;
static_assert(W_END <= 56 * MiB, "W region");
constexpr size_t O_HB = 56 * MiB;
constexpr size_t O_Y = O_HB + 64 * MiB;
constexpr size_t O_BIG = O_Y + 128 * MiB;
constexpr size_t SLACK = 4096;
constexpr size_t B_QN = 0;
constexpr size_t B_KCR = B_QN + 32 * MiB;
constexpr size_t B_VCR = B_KCR + 8 * MiB + SLACK;
constexpr size_t B_KS = B_VCR + 8 * MiB + SLACK;
constexpr size_t B_KW = B_KS + 8 * MiB + SLACK;
constexpr size_t B_VST = B_KW + 8 * MiB + SLACK;
constexpr size_t B_VWT = B_VST + 8 * MiB;
constexpr size_t B_GS = B_VWT + 8 * MiB;
constexpr size_t B_QR = B_GS + 3 * MiB;
constexpr size_t B_KR = B_QR + 32 * MiB;
constexpr size_t B_GR = B_KR + 32 * MiB;
constexpr size_t B_KRT = B_GR + 32 * MiB;
constexpr size_t B_VRT = B_KRT + 32 * MiB;
constexpr size_t B_END = B_VRT + 32 * MiB;
static_assert(B_END <= 244 * MiB, "BIG region");
constexpr size_t O_SMALL = O_BIG + 244 * MiB;
constexpr size_t S_HC = 0;
constexpr size_t S_KCC = S_HC + 4 * MiB;
constexpr size_t S_VCT = S_KCC + 512 * 1024;
constexpr size_t S_MEMN = S_VCT + 512 * 1024;
constexpr size_t S_KMEM = S_MEMN + 2 * MiB;
constexpr size_t S_VMEMT = S_KMEM + 1 * MiB;
constexpr size_t S_BAR = S_VMEMT + 1 * MiB;
constexpr size_t S_END = S_BAR + 16384;
constexpr size_t WS_NEED = O_SMALL + S_END;
static_assert(WS_NEED <= 512 * MiB, "workspace");

constexpr int KEYSTR = 260;
constexpr int SMEM_BYTES = 8 * 16 * KEYSTR * 4;
constexpr int LDSS = 72;

struct P {
  const float *x, *mem, *ffn1_pre_g, *ffn1_wg, *ffn1_wu, *ffn1_wd, *ffn1_post_g, *mix_pre_g, *w_in, *cmp_pe,
      *cmp_w1, *cmp_w2, *nsa_out_g, *ret_gn_g, *w_out, *mix_post_g, *xa_pre_g, *xa_mem_g, *xa_wq, *xa_wk, *xa_wv,
      *xa_wo, *xa_post_g, *ffn2_pre_g, *ffn2_wg, *ffn2_wu, *ffn2_wd, *ffn2_post_g;
  float* out;
  unsigned char* ws;
};

__device__ __forceinline__ u16 f2bf(float f) {
  u32 u = __float_as_uint(f);
  u += 0x7FFFu + ((u >> 16) & 1u);
  return (u16)(u >> 16);
}
__device__ __forceinline__ float bf2f(u16 h) { return __uint_as_float(((u32)h) << 16); }
typedef __bf16 bf16v2_t __attribute__((ext_vector_type(2)));
typedef float f32x2_t __attribute__((ext_vector_type(2)));
__device__ __forceinline__ u32 pack2(float a, float b) {
  f32x2_t v = {a, b};
  bf16v2_t h = __builtin_convertvector(v, bf16v2_t);
  return __builtin_bit_cast(u32, h);
}
__device__ __forceinline__ float silu_f(float v) { return v * __builtin_amdgcn_rcpf(1.f + __expf(-v)); }
__device__ __forceinline__ float sigm_f(float v) { return __builtin_amdgcn_rcpf(1.f + __expf(-v)); }
__device__ __forceinline__ float shx(float v, int m) { return __shfl_xor(v, m, 64); }
__device__ __forceinline__ float wave_sum(float v) {
#pragma unroll
  for (int o = 32; o >= 1; o >>= 1) v += __shfl_xor(v, o, 64);
  return v;
}
__device__ __forceinline__ f32x4 mfma16(bf16x8 a, bf16x8 b, f32x4 c) {
  return __builtin_amdgcn_mfma_f32_16x16x32_bf16(a, b, c, 0, 0, 0);
}
__device__ __forceinline__ bf16x8 ld8(const u16* p) { return *reinterpret_cast<const bf16x8*>(p); }
__device__ __forceinline__ bf16x8 ld4x2(const u16* p0, const u16* p1) {
  u32x2 a = *reinterpret_cast<const u32x2*>(p0);
  u32x2 b = *reinterpret_cast<const u32x2*>(p1);
  u32x4 r = {a.x, a.y, b.x, b.y};
  return __builtin_bit_cast(bf16x8, r);
}
__device__ __forceinline__ bf16x8 packp(f32x4 a, f32x4 b) {
  u32x4 r = {pack2(a[0], a[1]), pack2(a[2], a[3]), pack2(b[0], b[1]), pack2(b[2], b[3])};
  return __builtin_bit_cast(bf16x8, r);
}
__device__ __forceinline__ void st4bf(u16* p, f32x4 v) {
  u32x2 r = {pack2(v[0], v[1]), pack2(v[2], v[3])};
  *reinterpret_cast<u32x2*>(p) = r;
}
__device__ __forceinline__ f32x4 bf4_to_f32(u32x2 r) {
  return f32x4{__uint_as_float(r.x << 16), __uint_as_float(r.x & 0xFFFF0000u), __uint_as_float(r.y << 16), __uint_as_float(r.y & 0xFFFF0000u)};
}
__device__ __forceinline__ float ret_lg(int h) { return log2f(1.f - exp2f(-5.f - (float)h)); }

__device__ __forceinline__ int tidx() {
  int t = threadIdx.x;
  asm volatile("" : "+v"(t));
  return t;
}
__device__ __forceinline__ int bidx() {
  int t = blockIdx.x;
  asm volatile("" : "+s"(t));
  return t;
}
__device__ __forceinline__ int gdim() {
  int t = gridDim.x;
  asm volatile("" : "+s"(t));
  return t;
}
__device__ __forceinline__ int wmap(int mode, int n) {
  if (mode == 1) return (n >> 7) * 256 + (n & 127);
  if (mode == 2) return (n >> 7) * 256 + 128 + (n & 127);
  if (mode == 3) return n < 1280 ? n : (n < 1304 ? 3328 + (n - 1280) : n - 24);
  return n;
}
__device__ __forceinline__ void tconv(const float* __restrict__ src, int K, int N, u16* __restrict__ dst, int mode, int& tbase,
                      float* tile) {
  const int nkt = K >> 6, nnt = (N + 63) >> 6, ntl = nkt * nnt;
  const int G = gdim();
  int tl0 = (bidx() - (tbase % G) + G) % G;
  const int tid = tidx();
  for (int tl = tl0; tl < ntl; tl += G) {
    const int k0 = (tl / nnt) << 6, n0 = (tl % nnt) << 6;
#pragma unroll
    for (int i = 0; i < 2; ++i) {
      const int kk = (tid >> 4) + i * 32, nn = (tid & 15) * 4;
      f32x4 v = {0.f, 0.f, 0.f, 0.f};
      if (n0 + nn < N) v = *reinterpret_cast<const f32x4*>(src + (size_t)(k0 + kk) * N + n0 + nn);
      tile[kk * 65 + nn + 0] = v[0];
      tile[kk * 65 + nn + 1] = v[1];
      tile[kk * 65 + nn + 2] = v[2];
      tile[kk * 65 + nn + 3] = v[3];
    }
    __syncthreads();
    {
      int nn = tid >> 3, ch = tid & 7;
      if (n0 + nn < N) {
        u32x4 r;
        r.x = pack2(tile[(ch * 8 + 0) * 65 + nn], tile[(ch * 8 + 1) * 65 + nn]);
        r.y = pack2(tile[(ch * 8 + 2) * 65 + nn], tile[(ch * 8 + 3) * 65 + nn]);
        r.z = pack2(tile[(ch * 8 + 4) * 65 + nn], tile[(ch * 8 + 5) * 65 + nn]);
        r.w = pack2(tile[(ch * 8 + 6) * 65 + nn], tile[(ch * 8 + 7) * 65 + nn]);
        *reinterpret_cast<u32x4*>(dst + (size_t)wmap(mode, n0 + nn) * K + k0 + ch * 8) = r;
      }
    }
    __syncthreads();
  }
  tbase += ntl;
}

__device__ __forceinline__ void convert_layer(const P& p, int l, unsigned char* smem) {
  float* tile = reinterpret_cast<float*>(smem);
  unsigned char* W = p.ws;
  int tb = 0;
  tconv(p.ffn1_wg + (size_t)l * DM * DFF, DM, DFF, (u16*)(W + W_GU1), 1, tb, tile);
  tconv(p.ffn1_wu + (size_t)l * DM * DFF, DM, DFF, (u16*)(W + W_GU1), 2, tb, tile);
  tconv(p.ffn1_wd + (size_t)l * DFF * DM, DFF, DM, (u16*)(W + W_D1), 0, tb, tile);
  tconv(p.w_in + (size_t)l * DM * 3352, DM, 3352, (u16*)(W + W_IN), 3, tb, tile);
  tconv(p.cmp_w1 + (size_t)(l * 2 + 0) * 2048 * 256, 2048, 256, (u16*)(W + W_C1), 0, tb, tile);
  tconv(p.cmp_w1 + (size_t)(l * 2 + 1) * 2048 * 256, 2048, 256, (u16*)(W + W_C1) + 256 * 2048, 0, tb, tile);
  tconv(p.cmp_w2 + (size_t)(l * 2 + 0) * 256 * 64, 256, 64, (u16*)(W + W_C2), 0, tb, tile);
  tconv(p.cmp_w2 + (size_t)(l * 2 + 1) * 256 * 64, 256, 64, (u16*)(W + W_C2) + 128 * 256, 0, tb, tile);
  tconv(p.w_out + (size_t)l * DM * DM, DM, DM, (u16*)(W + W_OUT), 0, tb, tile);
  tconv(p.xa_wq + (size_t)l * DM * DM, DM, DM, (u16*)(W + W_Q), 0, tb, tile);
  tconv(p.xa_wk + (size_t)l * DM * DM, DM, DM, (u16*)(W + W_K), 0, tb, tile);
  tconv(p.xa_wv + (size_t)l * DM * DM, DM, DM, (u16*)(W + W_V), 0, tb, tile);
  tconv(p.xa_wo + (size_t)l * DM * DM, DM, DM, (u16*)(W + W_O), 0, tb, tile);
  tconv(p.ffn2_wg + (size_t)l * DM * DFF, DM, DFF, (u16*)(W + W_GU2), 1, tb, tile);
  tconv(p.ffn2_wu + (size_t)l * DM * DFF, DM, DFF, (u16*)(W + W_GU2), 2, tb, tile);
  tconv(p.ffn2_wd + (size_t)l * DFF * DM, DFF, DM, (u16*)(W + W_D2), 0, tb, tile);
  const int gt = bidx() * 512 + tidx(), nt = gdim() * 512;
  {
    u32* z = reinterpret_cast<u32*>((u16*)(W + W_IN) + (size_t)3352 * 1024);
    for (int i = gt; i < 232 * 512; i += nt) z[i] = 0u;
    for (int kv = 0; kv < 2; ++kv) {
      u32* z2 = reinterpret_cast<u32*>((u16*)(W + W_C2) + (size_t)kv * 128 * 256 + 64 * 256);
      for (int i = gt; i < 64 * 128; i += nt) z2[i] = 0u;
    }
  }
  {
    float* red = reinterpret_cast<float*>(smem);
    const int tid = tidx(), kg = tid >> 6, cl = tid & 63;
    for (int job = gdim() - 1 - bidx(); job < 64; job += gdim()) {
      const int kv = job >> 5, ct = (job >> 3) & 3, kb = job & 7;
      const float* pe = p.cmp_pe + (size_t)(l * 2 + kv) * 2048 + kb * 256 + kg * 32;
      const float* w1 = p.cmp_w1 + ((size_t)(l * 2 + kv) * 2048 + kb * 256 + kg * 32) * 256 + ct * 64 + cl;
      float s = 0.f;
#pragma unroll 8
      for (int i = 0; i < 32; ++i) s += pe[i] * w1[(size_t)i * 256];
      __syncthreads();
      red[kg * 64 + cl] = s;
      __syncthreads();
      if (tid < 64) {
        float a = 0.f;
#pragma unroll
        for (int j = 0; j < 8; ++j) a += red[j * 64 + tid];
        reinterpret_cast<float*>(W + W_BIAS)[(kv * 8 + kb) * 256 + ct * 64 + tid] = a;
      }
    }
    __syncthreads();
  }
}

__device__ __forceinline__ void bf8_to_f32(u32x4 r, f32x4& a, f32x4& b) {
  a = f32x4{__uint_as_float(r.x << 16), __uint_as_float(r.x & 0xFFFF0000u), __uint_as_float(r.y << 16), __uint_as_float(r.y & 0xFFFF0000u)};
  b = f32x4{__uint_as_float(r.z << 16), __uint_as_float(r.z & 0xFFFF0000u), __uint_as_float(r.w << 16), __uint_as_float(r.w & 0xFFFF0000u)};
}
__device__ __forceinline__ void st8bf_n(u16* p, f32x4 a, f32x4 b) {
  u32x4 r = {pack2(a[0], a[1]), pack2(a[2], a[3]), pack2(b[0], b[1]), pack2(b[2], b[3])};
  *reinterpret_cast<u32x4*>(p) = r;
}
__device__ __forceinline__ void norm_phase(const float* __restrict__ xin_f, const u16* __restrict__ xin_b, const u16* __restrict__ y,
                                           const float* __restrict__ gpost, float w, u16* __restrict__ xout_b,
                                           float* __restrict__ xout_f, float* __restrict__ xout_f2,
                                           const float* __restrict__ gpre, u16* __restrict__ hb, int ntok) {
  const int lane = tidx() & 63;
  const int gw = bidx() * 8 + __builtin_amdgcn_readfirstlane(tidx() >> 6), nw = gdim() * 8;
  for (int tok = gw; tok < ntok; tok += nw) {
    f32x4 xv[4];
    if (xin_b) {
#pragma unroll
      for (int i = 0; i < 2; ++i) {
        u32x4 xr = *reinterpret_cast<const u32x4*>(xin_b + (size_t)tok * 1024 + i * 512 + lane * 8);
        bf8_to_f32(xr, xv[2 * i], xv[2 * i + 1]);
      }
    } else {
#pragma unroll
      for (int i = 0; i < 2; ++i) {
        xv[2 * i] = *reinterpret_cast<const f32x4*>(xin_f + (size_t)tok * 1024 + i * 512 + lane * 8);
        xv[2 * i + 1] = *reinterpret_cast<const f32x4*>(xin_f + (size_t)tok * 1024 + i * 512 + lane * 8 + 4);
      }
    }
    if (y) {
      f32x4 yv[4];
      float ss = 0.f;
#pragma unroll
      for (int i = 0; i < 2; ++i) {
        u32x4 yr = *reinterpret_cast<const u32x4*>(y + (size_t)tok * 1024 + i * 512 + lane * 8);
        bf8_to_f32(yr, yv[2 * i], yv[2 * i + 1]);
      }
#pragma unroll
      for (int q = 0; q < 4; ++q) ss += yv[q][0] * yv[q][0] + yv[q][1] * yv[q][1] + yv[q][2] * yv[q][2] + yv[q][3] * yv[q][3];
      ss = wave_sum(ss);
      float r = rsqrtf(ss * (1.f / 1024.f) + EPS) * w;
#pragma unroll
      for (int q = 0; q < 4; ++q) {
        f32x4 g = *reinterpret_cast<const f32x4*>(gpost + (q >> 1) * 512 + lane * 8 + (q & 1) * 4);
        xv[q] += yv[q] * g * r;
      }
    }
    if (xout_b) {
#pragma unroll
      for (int i = 0; i < 2; ++i) st8bf_n(xout_b + (size_t)tok * 1024 + i * 512 + lane * 8, xv[2 * i], xv[2 * i + 1]);
    }
    if (xout_f) {
      float* o = (tok < 16384 ? xout_f : xout_f2) + (size_t)tok * 1024;
#pragma unroll
      for (int q = 0; q < 4; ++q) *reinterpret_cast<f32x4*>(o + (q >> 1) * 512 + lane * 8 + (q & 1) * 4) = xv[q];
    }
    if (hb) {
      float ss = 0.f;
#pragma unroll
      for (int q = 0; q < 4; ++q) ss += xv[q][0] * xv[q][0] + xv[q][1] * xv[q][1] + xv[q][2] * xv[q][2] + xv[q][3] * xv[q][3];
      ss = wave_sum(ss);
      float r = rsqrtf(ss * (1.f / 1024.f) + EPS);
      f32x4 hv[4];
#pragma unroll
      for (int q = 0; q < 4; ++q) {
        f32x4 g = *reinterpret_cast<const f32x4*>(gpre + (q >> 1) * 512 + lane * 8 + (q & 1) * 4);
        hv[q] = xv[q] * g * r;
      }
#pragma unroll
      for (int i = 0; i < 2; ++i) st8bf_n(hb + (size_t)tok * 1024 + i * 512 + lane * 8, hv[2 * i], hv[2 * i + 1]);
    }
  }
}

enum { EP_SWIGLU = 0, EP_F32 = 1, EP_WIN = 2, EP_C1 = 3, EP_C2K = 4, EP_C2V = 5, EP_BF16 = 6, EP_VMEMT = 7 };

template <int MODE>
__device__ __forceinline__ void epi_store(const P& p, int aux, float scale, void* outp, int ldo, int row, int col,
                                          f32x4 v) {
  unsigned char* ws = p.ws;
  if constexpr (MODE == EP_F32) {
    float* o = (float*)outp;
#pragma unroll
    for (int i = 0; i < 4; ++i) o[(size_t)(row + i) * ldo + col] = v[i];
  } else if constexpr (MODE == EP_BF16) {
    u16* o = (u16*)outp;
#pragma unroll
    for (int i = 0; i < 4; ++i) o[(size_t)(row + i) * ldo + col] = f2bf(v[i] * scale);
  } else if constexpr (MODE == EP_C1) {
    u16* o = (u16*)outp;
    float bia = 0.f;
#pragma unroll
    for (int j = 0; j < 8; ++j) bia += reinterpret_cast<const float*>(ws + W_BIAS)[(aux * 8 + j) * 256 + col];
#pragma unroll
    for (int i = 0; i < 4; ++i) o[(size_t)(row + i) * 256 + col] = f2bf(silu_f(v[i] + bia));
  } else if constexpr (MODE == EP_C2K) {
    if (col < 64) {
      u16* o = (u16*)outp;
#pragma unroll
      for (int i = 0; i < 4; ++i) o[(size_t)(row + i) * 64 + col] = f2bf(v[i]);
    }
  } else if constexpr (MODE == EP_C2V) {
    if (col < 64) {
      u16* o = (u16*)outp;
      int bg = row >> 10, n = row & 1023;
      st4bf(o + (size_t)bg * 65536 + (size_t)(n >> 6) * 4096 + col * 64 + (n & 63), v);
    }
  } else if constexpr (MODE == EP_VMEMT) {
    u16* o = (u16*)outp;
    int b = row >> 8, m = row & 255;
    st4bf(o + ((size_t)b * 1024 + col) * 256 + m, v);
  } else if constexpr (MODE == EP_WIN) {
    unsigned char* big = ws + O_BIG;
    const int b = row >> 14, t = row & 16383;
    if (col < 512) {
      u16* o = (u16*)(big + B_QN);
#pragma unroll
      for (int i = 0; i < 4; ++i) o[(size_t)(row + i) * 512 + col] = f2bf(v[i] * 0.125f);
    } else if (col < 1280) {
      const int s = (col - 512) >> 7, cc = (col - 512) & 127, g = cc >> 6, d = cc & 63, bg = b * 2 + g;
      if (s == 3 || s == 5) {
        u16* o = (u16*)(big + (s == 3 ? B_VST : B_VWT));
        st4bf(o + ((size_t)(bg * 256 + (t >> 6)) * 4096 + d * 64 + (t & 63)), v);
      } else {
        u16* o = (u16*)(big + (s == 0 ? B_KCR : (s == 1 ? B_VCR : (s == 2 ? B_KS : B_KW))));
        o += ((size_t)bg * T + t) * 64 + d;
#pragma unroll
        for (int i = 0; i < 4; ++i) o[i * 64] = f2bf(v[i]);
      }
    } else if (col < 3328) {
      const int cr = col - 1280, wh = cr >> 9, cc = cr & 511, h = cc >> 7, d = cc & 127;
      const float s128 = 0.08838834764831845f;
      if (wh == 0) {
        u16* o = (u16*)(big + B_QR);
#pragma unroll
        for (int i = 0; i < 4; ++i) o[(size_t)(row + i) * 512 + cc] = f2bf(v[i]);
      } else if (wh == 1) {
        u16* o = (u16*)(big + B_KR);
#pragma unroll
        for (int i = 0; i < 4; ++i) o[(size_t)(row + i) * 512 + cc] = f2bf(v[i] * s128);
        u16* ot = (u16*)(big + B_KRT);
        const float lg = ret_lg(h);
        const int tm = t & 127;
        f32x4 w;
#pragma unroll
        for (int i = 0; i < 4; ++i) w[i] = v[i] * s128 * exp2f((float)(127 - tm - i) * lg);
        st4bf(ot + ((size_t)((b * 4 + h) * 128 + (t >> 7)) * 16384 + d * 128 + tm), w);
      } else if (wh == 2) {
        u16* ot = (u16*)(big + B_VRT);
        st4bf(ot + ((size_t)((b * 4 + h) * 128 + (t >> 7)) * 16384 + d * 128 + (t & 127)), v);
      } else {
        u16* o = (u16*)(big + B_GR);
#pragma unroll
        for (int i = 0; i < 4; ++i) o[(size_t)(row + i) * 512 + cc] = f2bf(silu_f(v[i]));
      }
    } else if (col < 3352) {
      float* o = (float*)(big + B_GS);
#pragma unroll
      for (int i = 0; i < 4; ++i) o[(size_t)(row + i) * 24 + (col - 3328)] = sigm_f(v[i]);
    }
  }
}

template <int MODE>
__device__ __forceinline__ void gemm_tile(const P& p, int aux, float scale, void* outp, int ldo, const u16* __restrict__ A, size_t lda,
                          const u16* __restrict__ Bt, size_t ldb, int K, int brow, int bcol, u16* sm) {
  const int tid = tidx(), lane = tid & 63, wid = __builtin_amdgcn_readfirstlane(tid >> 6);
  const int wr = wid >> 1, wc = wid & 1, fr = lane & 15, fq = lane >> 4;
  u16* smA = sm;
  u16* smB = sm + 2 * 256 * LDSS;
  f32x4 acc[4][4];
#pragma unroll
  for (int m = 0; m < 4; ++m)
#pragma unroll
    for (int n = 0; n < 4; ++n) acc[m][n] = f32x4{0.f, 0.f, 0.f, 0.f};
  u32x4 ra[4], rb[2];
  const int nt = K >> 6;
  auto gload = [&](int kt) {
#pragma unroll
    for (int i = 0; i < 4; ++i) {
      int c = tid + i * 512;
      ra[i] = *reinterpret_cast<const u32x4*>(A + (size_t)(brow + (c >> 3)) * lda + (size_t)kt * 64 + (c & 7) * 8);
    }
#pragma unroll
    for (int i = 0; i < 2; ++i) {
      int c = tid + i * 512;
      rb[i] = *reinterpret_cast<const u32x4*>(Bt + (size_t)(bcol + (c >> 3)) * ldb + (size_t)kt * 64 + (c & 7) * 8);
    }
  };
  auto swrite = [&](int buf) {
#pragma unroll
    for (int i = 0; i < 4; ++i) {
      int c = tid + i * 512;
      *reinterpret_cast<u32x4*>(smA + buf * 256 * LDSS + (c >> 3) * LDSS + (c & 7) * 8) = ra[i];
    }
#pragma unroll
    for (int i = 0; i < 2; ++i) {
      int c = tid + i * 512;
      *reinterpret_cast<u32x4*>(smB + buf * 128 * LDSS + (c >> 3) * LDSS + (c & 7) * 8) = rb[i];
    }
  };
  gload(0);
  swrite(0);
  __syncthreads();
  for (int kt = 0; kt < nt; ++kt) {
    const int buf = kt & 1;
    if (kt + 1 < nt) gload(kt + 1);
    const u16* a0 = smA + buf * 256 * LDSS + (wr * 64 + fr) * LDSS + fq * 8;
    const u16* b0 = smB + buf * 128 * LDSS + (wc * 64 + fr) * LDSS + fq * 8;
#pragma unroll
    for (int ks = 0; ks < 2; ++ks) {
      bf16x8 af[4], bfr[4];
#pragma unroll
      for (int m = 0; m < 4; ++m) af[m] = ld8(a0 + m * 16 * LDSS + ks * 32);
#pragma unroll
      for (int n = 0; n < 4; ++n) bfr[n] = ld8(b0 + n * 16 * LDSS + ks * 32);
#pragma unroll
      for (int m = 0; m < 4; ++m)
#pragma unroll
        for (int n = 0; n < 4; ++n) acc[m][n] = mfma16(af[m], bfr[n], acc[m][n]);
    }
    if (kt + 1 < nt) swrite(buf ^ 1);
    __syncthreads();
  }
#pragma unroll
  for (int m = 0; m < 4; ++m) {
    const int row = brow + wr * 64 + m * 16 + fq * 4;
    if constexpr (MODE == EP_SWIGLU) {
#pragma unroll
      for (int n = 0; n < 4; n += 2) {
        const int cb = bcol + wc * 64 + n * 16;
        const int oc = (cb >> 5) * 16 + fr;
        u16* o = (u16*)outp;
#pragma unroll
        for (int i = 0; i < 4; ++i)
          o[(size_t)(row + i) * DFF + oc] = f2bf(silu_f(acc[m][n][i]) * acc[m][n + 1][i]);
      }
    } else {
#pragma unroll
      for (int n = 0; n < 4; ++n)
        epi_store<MODE>(p, aux, scale, outp, ldo, row, bcol + wc * 64 + n * 16 + fr, acc[m][n]);
    }
  }
}

template <int MODE>
__device__ __forceinline__ void gemm_phase(const P& p, int aux, float scale, void* outp, int ldo, const u16* A, size_t lda,
                           const u16* Bt, size_t ldb, int M, int N, int K, u16* sm, int rev) {
  const int nNt = N >> 7, ntl = (M >> 8) * nNt;
  const int bid = (bidx() + gdim() - rev) % gdim();
  for (int tl = bid; tl < ntl; tl += gdim())
    gemm_tile<MODE>(p, aux, scale, outp, ldo, A, lda, Bt, ldb, K, (tl / nNt) << 8, (tl % nNt) << 7, sm);
}

namespace pg8 {
#define PG8_LAS __attribute__((address_space(3)))
typedef unsigned short bf16_t;
typedef short bf16x8 __attribute__((ext_vector_type(8)));
typedef float f32x4 __attribute__((ext_vector_type(4)));
typedef unsigned u32x4 __attribute__((ext_vector_type(4)));
constexpr int BM = 256, BK = 64, HALF = 128, HTB = HALF * BK * 2  , STAGE_BYTES = 8 * HTB, NXCD = 8, WGM = 8;

__host__ __device__ __forceinline__ int lds_byte(int r, int c) { const int st = (r >> 4) * 2 + (c >> 5), rr = r & 15, cc = c & 31, ob = rr * 64 + cc * 2; return st * 1024 + (ob ^ (((ob >> 9) & 1) << 5)); }
__host__ __device__ __forceinline__ void stage_rc(int b, int& R, int& C) { const int st = b / 1024, sb = b % 1024, swz = sb ^ (((sb >> 9) & 1) << 5); R = (st >> 1) * 16 + swz / 64; C = (st & 1) * 32 + (swz % 64) / 2; }
__host__ __device__ __forceinline__ int perm32(int rho) { const int n = rho >> 4, i = rho & 15; return 8 * (i >> 2) + 4 * n + (i & 3); }

struct Unit { int pm, pn; };
struct Gemm { const bf16_t* A; const bf16_t* Bt; int M, N, K, lda, ldb; };

struct StaticOrder {
    int nM, nN, nwg, G, c;
    __host__ __device__ void init(int M, int N, int G_, int c_) { nM = M / BM; nN = N / BM; nwg = nM * nN; G = G_; c = c_; }
    __host__ __device__ bool next(int i, Unit& u) const {
        const long L = (long)i * G + c; if (L >= nwg) return false;
        int wgid = (int)L; { const int q = nwg / NXCD, r = nwg % NXCD, xcd = wgid % NXCD, off = wgid / NXCD; wgid = (xcd < r ? xcd * (q + 1) : r * (q + 1) + (xcd - r) * q) + off; }
        const int nig = WGM * nN, gid = wgid / nig, fm = gid * WGM, gsz = (nM - fm) < WGM ? (nM - fm) : WGM;
        u.pm = fm + ((wgid % nig) % gsz); u.pn = (wgid % nig) / gsz; return true;
    }
    __device__ __forceinline__ void a_ready(const Unit&) const {}
    __device__ __forceinline__ void done(const Unit&) const {}
};
__device__ __forceinline__ unsigned cvt_pk_bf16(float lo, float hi) { unsigned r; asm volatile("v_cvt_pk_bf16_f32 %0, %1, %2" : "=v"(r) : "v"(lo), "v"(hi)); return r; }
template <class Epi, class Sched, bool STAMP = false>
__device__ __forceinline__ void gemm_phase(PG8_LAS unsigned char* lds, const Gemm g, const Sched& S, const Epi& E, unsigned long long* stamps) {
    const int tid = tidx(), wid = __builtin_amdgcn_readfirstlane(tid >> 6), lane = tid & 63, wr = wid >> 2, wc = wid & 3, fr = lane & 15, fq = lane >> 4;
    const int K = g.K, nt = K / BK;
    int ts_lo = 0, ts_hi = 0, nts = 0; const unsigned long long rt_entry = STAMP ? (unsigned long long)wall_clock64() : 0ull;
#define PG8_STAMP() do { if (STAMP && wid == 0 && nts < 64) { const unsigned long long _c = (unsigned long long)clock64(); \
        ts_lo = (lane == nts) ? (int)(unsigned)_c : ts_lo; ts_hi = (lane == nts) ? (int)(unsigned)(_c >> 32) : ts_hi; ++nts; } } while (0)
    PG8_STAMP();
    unsigned voffA[2], voffB[2];
#pragma unroll
    for (int i = 0; i < 2; ++i) { int R, C; stage_rc(tid * 16 + i * 8192, R, C); const int Rb = Epi::PERM ? ((R & ~31) + perm32(R & 31)) : R;
        voffA[i] = (unsigned)(R * g.lda + C) * 2u; voffB[i] = (unsigned)(Rb * g.ldb + C) * 2u; }
    const size_t kstep = (size_t)(BK * 2);
    const size_t hstepA = (size_t)HALF * g.lda * 2, hstepB = (size_t)HALF * g.ldb * 2;
    const size_t tstepA = 2 * hstepA, tstepB = 2 * hstepB;
    const unsigned ldsw = (unsigned)wid * 1024u;
    const int aoff = lds_byte(wr * 64 + fr, fq * 8), boff = lds_byte(wc * 32 + fr, fq * 8);
#define PG8_SA(b, h) (((b) * 2 + (h)) * HTB)
#define PG8_SB(b, h) ((4 + (b) * 2 + (h)) * HTB)
#define PG8_STAGE(bufoff, gbase, voff) do { _Pragma("unroll") for (int _i = 0; _i < 2; ++_i) \
        __builtin_amdgcn_global_load_lds((const unsigned*)((const char*)(gbase) + (voff)[_i]), (PG8_LAS unsigned*)(lds + (bufoff) + ldsw + _i * 8192), 16, 0, 0); } while (0)
#define PG8_LDA(dst, b, h) do { _Pragma("unroll") for (int m = 0; m < 4; ++m) _Pragma("unroll") for (int k = 0; k < 2; ++k) dst[m][k] = *(const PG8_LAS bf16x8*)(lds + PG8_SA(b, h) + aoff + m * 2048 + k * 1024); } while (0)
#define PG8_LDB(dst, b, h) do { _Pragma("unroll") for (int n = 0; n < 2; ++n) _Pragma("unroll") for (int k = 0; k < 2; ++k) dst[n][k] = *(const PG8_LAS bf16x8*)(lds + PG8_SB(b, h) + boff + n * 2048 + k * 1024); } while (0)
#define PG8_MMA(ai, bj, At, Bt) do { __builtin_amdgcn_s_setprio(1); _Pragma("unroll") for (int m = 0; m < 4; ++m) _Pragma("unroll") for (int n = 0; n < 2; ++n) _Pragma("unroll") for (int k = 0; k < 2; ++k) \
        acc[ai][bj][m][n] = __builtin_amdgcn_mfma_f32_16x16x32_bf16(Bt[n][k], At[m][k], acc[ai][bj][m][n], 0, 0, 0); __builtin_amdgcn_s_setprio(0); } while (0)
#define PG8_WAIT_V(n) asm volatile("s_waitcnt vmcnt(" #n ")" ::: "memory")
#define PG8_WAIT_L(n) asm volatile("s_waitcnt lgkmcnt(" #n ")" ::: "memory")
#define PG8_BAR __builtin_amdgcn_s_barrier()
#define PG8_SCHED __builtin_amdgcn_sched_barrier(0)
    Unit cur, nxt; int ui = 0;
    if (!S.next(0, cur)) return;
    f32x4 acc[2][2][4][2];
#pragma unroll
    for (int a = 0; a < 2; ++a)
#pragma unroll
        for (int b = 0; b < 2; ++b)
#pragma unroll
            for (int m = 0; m < 4; ++m)
#pragma unroll
                for (int n = 0; n < 2; ++n) acc[a][b][m][n] = (f32x4){0.f, 0.f, 0.f, 0.f};
    bf16x8 At[4][2], B0[2][2], B1[2][2];
    const char* cA = (const char*)g.A + (size_t)cur.pm * tstepA; const char* cB = (const char*)g.Bt + (size_t)cur.pn * tstepB;
    S.a_ready(cur);
    PG8_STAGE(PG8_SB(0, 0), cB, voffB); PG8_STAGE(PG8_SA(0, 0), cA, voffA); PG8_STAGE(PG8_SB(0, 1), cB + hstepB, voffB); PG8_STAGE(PG8_SA(0, 1), cA + hstepA, voffA);
    if (wr == 1) PG8_BAR;
    PG8_WAIT_V(4); PG8_BAR;
    PG8_STAGE(PG8_SB(1, 0), cB + kstep, voffB); PG8_STAGE(PG8_SA(1, 0), cA + kstep, voffA); PG8_STAGE(PG8_SB(1, 1), cB + hstepB + kstep, voffB);
    PG8_WAIT_V(6); PG8_BAR;
    PG8_STAMP();
    for (;;) {
        const bool has_next = S.next(ui + 1, nxt);
        const char* nA = has_next ? (const char*)g.A + (size_t)nxt.pm * tstepA : cA; const char* nB = has_next ? (const char*)g.Bt + (size_t)nxt.pn * tstepB : cB;
        for (int t = 0; t < nt; t += 2) {
            const bool last = (t == nt - 2);
            const char* a1 = cA + (size_t)(t + 1) * kstep;
            const char* a2 = last ? nA : cA + (size_t)(t + 2) * kstep; const char* b2 = last ? nB : cB + (size_t)(t + 2) * kstep;
            const char* a3 = a2 + kstep; const char* b3 = b2 + kstep;
            if (last && has_next) S.a_ready(nxt);
            PG8_LDB(B0, 0, 0); PG8_SCHED; PG8_LDA(At, 0, 0); PG8_STAGE(PG8_SA(1, 1), a1 + hstepA, voffA);
            PG8_WAIT_L(8); PG8_BAR; PG8_WAIT_L(0); PG8_MMA(0, 0, At, B0); PG8_BAR; PG8_SCHED;
            PG8_LDB(B1, 0, 1); PG8_STAGE(PG8_SB(0, 0), b2, voffB);
            PG8_BAR; PG8_WAIT_L(0); PG8_MMA(0, 1, At, B1); PG8_BAR;
            PG8_LDA(At, 0, 1); PG8_STAGE(PG8_SA(0, 0), a2, voffA);
            PG8_BAR; PG8_WAIT_L(0); PG8_MMA(1, 0, At, B0); PG8_BAR; PG8_SCHED;
            PG8_STAGE(PG8_SB(0, 1), b2 + hstepB, voffB);
            PG8_WAIT_V(6); PG8_BAR; PG8_MMA(1, 1, At, B1); PG8_BAR;
            PG8_LDB(B0, 1, 0); PG8_SCHED; PG8_LDA(At, 1, 0); PG8_STAGE(PG8_SA(0, 1), a2 + hstepA, voffA);
            PG8_WAIT_L(8); PG8_BAR; PG8_WAIT_L(0); PG8_MMA(0, 0, At, B0); PG8_BAR; PG8_SCHED;
            PG8_LDB(B1, 1, 1); PG8_STAGE(PG8_SB(1, 0), b3, voffB);
            PG8_BAR; PG8_WAIT_L(0); PG8_MMA(0, 1, At, B1); PG8_BAR;
            PG8_LDA(At, 1, 1); PG8_STAGE(PG8_SA(1, 0), a3, voffA);
            PG8_BAR; PG8_WAIT_L(0); PG8_MMA(1, 0, At, B0); PG8_BAR; PG8_SCHED;
            PG8_STAGE(PG8_SB(1, 1), b3 + hstepB, voffB);
            PG8_WAIT_V(6); PG8_BAR; PG8_MMA(1, 1, At, B1); PG8_BAR;
        }
        PG8_STAMP();
        if constexpr (!Epi::AFTER_DRAIN) { E(acc, cur, wr, wc, fr, fq); S.done(cur); }
        PG8_STAMP();
        if (!has_next) break;
#pragma unroll
        for (int a = 0; a < 2; ++a)
#pragma unroll
            for (int b = 0; b < 2; ++b)
#pragma unroll
                for (int m = 0; m < 4; ++m)
#pragma unroll
                    for (int n = 0; n < 2; ++n) acc[a][b][m][n] = (f32x4){0.f, 0.f, 0.f, 0.f};
        cur = nxt; cA = nA; cB = nB; ++ui;
    }
    PG8_WAIT_V(0);
    if (wr == 0) PG8_BAR;
    PG8_BAR;
    if constexpr (Epi::AFTER_DRAIN) { E.fused(acc, cur, wr, wc, fr, fq, lds, wid, lane); S.done(cur); }
    PG8_STAMP();
    if (STAMP && wid == 0) { stamps[lane] = lane < nts ? (((unsigned long long)(unsigned)ts_hi << 32) | (unsigned)ts_lo) : 0ull;
        if (lane == 62) stamps[62] = rt_entry; if (lane == 63) stamps[63] = (unsigned long long)wall_clock64(); }
#undef PG8_STAMP
#undef PG8_SA
#undef PG8_SB
#undef PG8_STAGE
#undef PG8_LDA
#undef PG8_LDB
#undef PG8_MMA
#undef PG8_WAIT_V
#undef PG8_WAIT_L
#undef PG8_BAR
#undef PG8_SCHED
}
}

__device__ __forceinline__ void st8bf(u16* p, f32x4 a, f32x4 b) {
  u32x4 r = {pack2(a[0], a[1]), pack2(a[2], a[3]), pack2(b[0], b[1]), pack2(b[2], b[3])};
  *reinterpret_cast<u32x4*>(p) = r;
}
struct EpiY {
  static constexpr bool PERM = true, AFTER_DRAIN = false;
  u16* C; int ldc;
  __device__ __forceinline__ void operator()(const pg8::f32x4 (&acc)[2][2][4][2], const pg8::Unit& u, int wr, int wc, int fr, int fq) const {
    const int row0 = u.pm * 256 + wr * 64 + fr, col0 = u.pn * 256 + wc * 32 + 8 * fq;
#pragma unroll
    for (int ai = 0; ai < 2; ++ai)
#pragma unroll
      for (int m = 0; m < 4; ++m) {
        u16* rowp = C + (size_t)(row0 + ai * 128 + m * 16) * ldc + col0;
#pragma unroll
        for (int bj = 0; bj < 2; ++bj) st8bf(rowp + bj * 128, acc[ai][bj][m][0], acc[ai][bj][m][1]);
      }
  }
};
struct EpiSwiglu {
  static constexpr bool PERM = true, AFTER_DRAIN = false;
  u16* O;
  __device__ __forceinline__ void operator()(const pg8::f32x4 (&acc)[2][2][4][2], const pg8::Unit& u, int wr, int wc, int fr, int fq) const {
    const int row0 = u.pm * 256 + wr * 64 + fr, hb = u.pn * 128 + wc * 32 + 8 * fq;
#pragma unroll
    for (int ai = 0; ai < 2; ++ai)
#pragma unroll
      for (int m = 0; m < 4; ++m) {
        f32x4 v0, v1;
#pragma unroll
        for (int i = 0; i < 4; ++i) {
          v0[i] = silu_f(acc[ai][0][m][0][i]) * acc[ai][1][m][0][i];
          v1[i] = silu_f(acc[ai][0][m][1][i]) * acc[ai][1][m][1][i];
        }
        st8bf(O + (size_t)(row0 + ai * 128 + m * 16) * DFF + hb, v0, v1);
      }
  }
};
struct EpiQ {
  static constexpr bool PERM = true, AFTER_DRAIN = false;
  u16* O; float scale;
  __device__ __forceinline__ void operator()(const pg8::f32x4 (&acc)[2][2][4][2], const pg8::Unit& u, int wr, int wc, int fr, int fq) const {
    const int row0 = u.pm * 256 + wr * 64 + fr, col0 = u.pn * 256 + wc * 32 + 8 * fq;
#pragma unroll
    for (int ai = 0; ai < 2; ++ai)
#pragma unroll
      for (int m = 0; m < 4; ++m) {
        u16* rowp = O + (size_t)(row0 + ai * 128 + m * 16) * 1024 + col0;
#pragma unroll
        for (int bj = 0; bj < 2; ++bj) st8bf(rowp + bj * 128, acc[ai][bj][m][0] * scale, acc[ai][bj][m][1] * scale);
      }
  }
};
struct EpiWin {
  static constexpr bool PERM = true, AFTER_DRAIN = false;
  unsigned char* big;
  __device__ __forceinline__ void operator()(const pg8::f32x4 (&acc)[2][2][4][2], const pg8::Unit& u, int wr, int wc, int fr, int fq) const {
    const int row0 = u.pm * 256 + wr * 64 + fr;
    const int b = u.pm >> 6;
    const float s128 = 0.08838834764831845f;
#pragma unroll
    for (int bj = 0; bj < 2; ++bj) {
      const int cb = u.pn * 256 + bj * 128 + wc * 32;
      if (cb >= 3352) continue;
      u16* rmb = nullptr; int ld = 0; float rsc = 1.f; bool act = false;
      u16* trb = nullptr; int X = 0, sh = 6; bool dec = false; float lg = 0.f; int dcol = 0;
      if (cb < 512) { rmb = (u16*)(big + B_QN) + cb; ld = 512; rsc = 0.125f * 1.4426950408889634f; }
      else if (cb < 1280) {
        const int s = (cb - 512) >> 7, cc = (cb - 512) & 127, g = cc >> 6, d = cc & 63, bg = b * 2 + g;
        if (s == 3 || s == 5) { trb = (u16*)(big + (s == 3 ? B_VST : B_VWT)); X = bg * 256; sh = 6; dcol = d; }
        else { rmb = (u16*)(big + (s == 0 ? B_KCR : (s == 1 ? B_VCR : (s == 2 ? B_KS : B_KW)))) + (size_t)(b + g) * T * 64 + d; ld = 64; }
      } else if (cb < 3328) {
        const int cr = cb - 1280, wh = cr >> 9, cc = cr & 511, h = cc >> 7, d = cc & 127;
        if (wh == 0) { rmb = (u16*)(big + B_QR) + cc; ld = 512; }
        else if (wh == 1) { rmb = (u16*)(big + B_KR) + cc; ld = 512; rsc = s128;
                            trb = (u16*)(big + B_KRT); X = (b * 4 + h) * 128; sh = 7; dcol = d; dec = true; lg = ret_lg(h); }
        else if (wh == 2) { trb = (u16*)(big + B_VRT); X = (b * 4 + h) * 128; sh = 7; dcol = d; }
        else { rmb = (u16*)(big + B_GR) + cc; ld = 512; act = true; }
      }
      if (cb >= 3328) {
#pragma unroll
        for (int n = 0; n < 2; ++n) {
          const int gc = 8 * fq + 4 * n;
          if (gc < 24) {
#pragma unroll
            for (int ai = 0; ai < 2; ++ai)
#pragma unroll
              for (int m = 0; m < 4; ++m) {
                const int row = row0 + ai * 128 + m * 16;
                f32x4 v = acc[ai][bj][m][n], w4;
#pragma unroll
                for (int i = 0; i < 4; ++i) w4[i] = sigm_f(v[i]);
                *(f32x4*)((float*)(big + B_GS) + (size_t)row * 24 + gc) = w4;
              }
          }
        }
        continue;
      }
      if (rmb) {
#pragma unroll
        for (int ai = 0; ai < 2; ++ai)
#pragma unroll
          for (int m = 0; m < 4; ++m) {
            const int row = row0 + ai * 128 + m * 16;
            f32x4 v0 = acc[ai][bj][m][0] * rsc, v1 = acc[ai][bj][m][1] * rsc;
            if (act) {
#pragma unroll
              for (int i = 0; i < 4; ++i) { v0[i] = silu_f(v0[i]); v1[i] = silu_f(v1[i]); }
            }
            st8bf(rmb + (size_t)row * ld + 8 * fq, v0, v1);
          }
      }
      if (trb) {
        const int msk = (1 << sh) - 1;
#pragma unroll
        for (int n = 0; n < 2; ++n)
#pragma unroll
          for (int ai = 0; ai < 2; ++ai)
#pragma unroll
            for (int m = 0; m < 4; ++m) {
              const int t = (row0 + ai * 128 + m * 16) & 16383;
              u16* o = trb + ((size_t)(X + (t >> sh)) << (2 * sh)) + (t & msk) + ((size_t)(dcol + 8 * fq + 4 * n) << sh);
              const float sc = dec ? s128 * exp2f((float)(127 - (t & 127)) * lg) : 1.f;
              f32x4 v = acc[ai][bj][m][n] * sc;
              const u32 p01 = pack2(v[0], v[1]), p23 = pack2(v[2], v[3]);
              o[0] = (u16)p01;
              o[(size_t)1 << sh] = (u16)(p01 >> 16);
              o[(size_t)2 << sh] = (u16)p23;
              o[(size_t)3 << sh] = (u16)(p23 >> 16);
            }
      }
    }
  }
};
template <class Epi>
__device__ __forceinline__ void big_gemm(unsigned char* smem, const u16* A, const u16* Bt, int M, int N, int K, const Epi& E,
                                         int lda = 0, int boff = 0) {
  pg8::Gemm g{A, Bt, M, N, K, lda ? lda : K, K};
  pg8::StaticOrder S;
  const int G = gdim();
  S.init(M, N, G, (bidx() + G - boff) % G);
  pg8::gemm_phase<Epi, pg8::StaticOrder, false>((PG8_LAS unsigned char*)smem, g, S, E, nullptr);
}
struct EpiC1 {
  static constexpr bool PERM = false, AFTER_DRAIN = false;
  u16* O; const float* bias;
  __device__ __forceinline__ void operator()(const pg8::f32x4 (&acc)[2][2][4][2], const pg8::Unit& u, int wr, int wc, int fr, int fq) const {
    const int row0 = u.pm * 256 + wr * 64 + fr, col0 = wc * 32 + 4 * fq;
#pragma unroll
    for (int bj = 0; bj < 2; ++bj)
#pragma unroll
      for (int n = 0; n < 2; ++n) {
        const int col = col0 + bj * 128 + n * 16;
        f32x4 bv = {0.f, 0.f, 0.f, 0.f};
#pragma unroll 1
        for (int j = 0; j < 8; ++j) bv += *(const f32x4*)(bias + j * 256 + col);
#pragma unroll
        for (int ai = 0; ai < 2; ++ai)
#pragma unroll
          for (int m = 0; m < 4; ++m) {
            f32x4 v = acc[ai][bj][m][n] + bv, w;
#pragma unroll
            for (int i = 0; i < 4; ++i) w[i] = silu_f(v[i]);
            st4bf(O + (size_t)(row0 + ai * 128 + m * 16) * 256 + col, w);
          }
      }
  }
};

__device__ __forceinline__ void ld_kfp(const u16* __restrict__ kp, bf16x8 (&Kf)[2][2], int krow0, int fq) {
#pragma unroll
  for (int tl = 0; tl < 2; ++tl)
#pragma unroll
    for (int ks = 0; ks < 2; ++ks) Kf[tl][ks] = ld8(kp + (krow0 + tl * 4) * 64 + ks * 32 + fq * 8);
}
__device__ __forceinline__ void ld_vfp(const u16* __restrict__ vp, bf16x8 (&Vf)[4], int fr, int fq) {
#pragma unroll
  for (int dt = 0; dt < 4; ++dt) Vf[dt] = ld8(vp + ((dt >> 1) * 32 + (fr >> 2) * 8 + (dt & 1) * 4 + (fr & 3)) * 64 + fq * 8);
}
__device__ __forceinline__ void qk_r(const bf16x8 (&Kf)[2][2], const bf16x8 (&Qr)[2], f32x4& s0, f32x4& s1) {
  f32x4 z = {0.f, 0.f, 0.f, 0.f};
  s0 = mfma16(Kf[0][0], Qr[0], z);
  s0 = mfma16(Kf[0][1], Qr[1], s0);
  s1 = mfma16(Kf[1][0], Qr[0], z);
  s1 = mfma16(Kf[1][1], Qr[1], s1);
}
__device__ __forceinline__ void pv_tiles(const bf16x8 (&Vf)[4], const bf16x8 (&Pb)[4], f32x4 (&O)[4][4]) {
#pragma unroll
  for (int dt = 0; dt < 4; ++dt)
#pragma unroll
    for (int r = 0; r < 4; ++r) O[r][dt] = mfma16(Vf[dt], Pb[r], O[r][dt]);
}

template <int MODE, bool MASKED>
__device__ __forceinline__ void att_step(const bf16x8 (&Kc)[2][2], const bf16x8 (&Vc)[4], int d0, bool selq, const bf16x8* qlds,
                                         int lane, const float (&slope)[4], float (&m)[4], float (&ls)[4], f32x4 (&O)[4][4]) {
  float fd[2][4];
#pragma unroll
  for (int tl = 0; tl < 2; ++tl)
#pragma unroll
    for (int i = 0; i < 4; ++i) {
      const int dist = d0 - tl * 4 - i;
      bool v;
      if (MODE == 1) v = selq && (dist >= 0);
      else v = (dist >= 0) && (dist < 512);
      fd[tl][i] = (MASKED && !v) ? __builtin_inff() : (float)dist;
    }
  bf16x8 Pb[4];
#pragma unroll
  for (int r = 0; r < 4; ++r) {
    f32x4 sv[2];
    bf16x8 Qr[2];
    Qr[0] = qlds[(r * 2 + 0) * 64 + lane];
    Qr[1] = qlds[(r * 2 + 1) * 64 + lane];
    qk_r(Kc, Qr, sv[0], sv[1]);
    float mx = NEG;
#pragma unroll
    for (int tl = 0; tl < 2; ++tl)
#pragma unroll
      for (int i = 0; i < 4; ++i) {
        const float sc = __builtin_fmaf(-slope[r], fd[tl][i], sv[tl][i]);
        sv[tl][i] = sc;
        mx = fmaxf(mx, sc);
      }
    if (__any(mx > m[r] + 8.f)) {
      mx = fmaxf(mx, shx(mx, 16));
      mx = fmaxf(mx, shx(mx, 32));
      const float mn = fmaxf(m[r], mx);
      const float alpha = __builtin_amdgcn_exp2f(m[r] - mn);
      ls[r] *= alpha;
      m[r] = mn;
#pragma unroll
      for (int dt = 0; dt < 4; ++dt) O[r][dt] *= alpha;
    }
    float sum = 0.f;
#pragma unroll
    for (int tl = 0; tl < 2; ++tl)
#pragma unroll
      for (int i = 0; i < 4; ++i) {
        const float pv = __builtin_amdgcn_exp2f(sv[tl][i] - m[r]);
        sv[tl][i] = pv;
        sum += pv;
      }
    ls[r] += sum;
    Pb[r] = packp(sv[0], sv[1]);
  }
  pv_tiles(Vc, Pb, O);
}

template <int MODE>
__device__ __forceinline__ void att_one(int e, const bf16x8 (&Kc)[2][2], const bf16x8 (&Vc)[4], int t, u64 mymask, const bf16x8* qlds,
                                        int lane, int fr, int fq, const float (&slope)[4], float (&m)[4], float (&ls)[4],
                                        f32x4 (&O)[4][4]) {
  const int d0 = t - (e * 32 + fq * 8);
  bool selq = true;
  if (MODE == 1) {
    const int j = e >> 1;
    const int sb = (int)((mymask >> (j & 63)) & 1ull);
    selq = __shfl(sb, fr + 16 * (j >> 6), 64) != 0;
  }
  att_step<MODE, true>(Kc, Vc, d0, selq, qlds, lane, slope, m, ls, O);
}
template <int MODE>
__device__ __forceinline__ void att_loop(int ns, const u32* list, const u16* __restrict__ Kb, const u16* __restrict__ Vb, int t,
                                         int t0, u64 mymask, const bf16x8* qlds, int lane, int fr, int fq, const float (&slope)[4],
                                         float (&m)[4], float (&ls)[4], f32x4 (&O)[4][4]) {
  if (ns <= 0) return;
  const int krow0 = (fr >> 2) * 8 + (fr & 3);
  bf16x8 Ka[2][2];
  int ea = __builtin_amdgcn_readfirstlane((int)list[ns - 1]);
  ld_kfp(Kb + (size_t)ea * 2048, Ka, krow0, fq);
#pragma unroll 1
  for (int s = ns - 1; s >= 0; --s) {
    bf16x8 Va[4], Kq[2][2];
    ld_vfp(Vb + (size_t)(ea >> 1) * 4096 + (ea & 1) * 32, Va, fr, fq);
    int eb = ea;
    if (s >= 1) {
      eb = __builtin_amdgcn_readfirstlane((int)list[s - 1]);
      ld_kfp(Kb + (size_t)eb * 2048, Kq, krow0, fq);
    }
    att_one<MODE>(ea, Ka, Va, t, mymask, qlds, lane, fr, fq, slope, m, ls, O);
    if (s >= 1) {
#pragma unroll
      for (int tl = 0; tl < 2; ++tl)
#pragma unroll
        for (int ks = 0; ks < 2; ++ks) Ka[tl][ks] = Kq[tl][ks];
    }
    ea = eb;
  }
}

__device__ __forceinline__ void nsa_task(const P& p, int l, int b, int qt, int g, u32* keys, float* xch, int wid) {
  int lane = tidx() & 63, fr = lane & 15, fq = lane >> 4;
#define LAUNDER() asm volatile("" : "+v"(fr), "+v"(fq), "+v"(lane))
  const int t0 = qt * 16, t = t0 + fr, cur = t0 >> 6;
  const size_t tok = (size_t)b * T + t;
  unsigned char* big = p.ws + O_BIG;
  const u16* QN = (const u16*)(big + B_QN);
  const float* GS = (const float*)(big + B_GS);
  float* ONSA = (float*)(p.ws + O_Y);
  u16* CAT = (u16*)(p.ws + O_HB);
  u32* krow = keys + fr * KEYSTR;
  float ssq = 0.f;
  f32x4 O[4][4];
  {
    const int bg = b * 2 + g;
    bf16x8 Qf[4][2];
    float slope[4];
#pragma unroll
    for (int r = 0; r < 4; ++r) {
#pragma unroll
      for (int ks = 0; ks < 2; ++ks) Qf[r][ks] = ld8(QN + tok * 512 + (g * 4 + r) * 64 + ks * 32 + fq * 8);
      slope[r] = exp2f(-(float)(g * 4 + r + 1)) * 1.4426950408889634f;
    }
    const float* gsp = GS + tok * 24 + g * 12;
    float* onp = ONSA + tok * 512 + g * 256 + fq * 4;
    const u16* Kc = (const u16*)(p.ws + O_SMALL + S_KCC) + (size_t)bg * 65536;
    const u16* Vc = (const u16*)(p.ws + O_SMALL + S_VCT) + (size_t)bg * 65536;
    float m[4], ls[4];
    const int nlast = (t0 + 15 - 31) >> 4;
    const int nit = nlast >= 0 ? (nlast >> 5) + 1 : 0;
    LAUNDER();
#pragma unroll
    for (int r = 0; r < 4; ++r) { m[r] = NEG; ls[r] = 0.f; }
    {
      const int krow0 = (fr >> 2) * 8 + (fr & 3);
      bf16x8 Kf[2][2];
      if (nit > 0) ld_kfp(Kc, Kf, krow0, fq);
#pragma unroll 1
      for (int it = 0; it < nit; ++it) {
        bf16x8 Kn[2][2];
        const bool more = (it + 1 < nit);
        if (more) ld_kfp(Kc + (size_t)(it + 1) * 2048, Kn, krow0, fq);
        const int n0 = it * 32 + fq * 8;
        float fd[2][4];
#pragma unroll
        for (int tl = 0; tl < 2; ++tl)
#pragma unroll
          for (int i = 0; i < 4; ++i) {
            const int n = n0 + tl * 4 + i;
            fd[tl][i] = (16 * n + 31 <= t) ? (float)t - (16.f * (float)n + 15.5f) : __builtin_inff();
          }
#pragma unroll
        for (int r = 0; r < 4; ++r) {
          f32x4 sv[2];
          qk_r(Kf, Qf[r], sv[0], sv[1]);
          float mx = m[r];
#pragma unroll
          for (int tl = 0; tl < 2; ++tl)
#pragma unroll
            for (int i = 0; i < 4; ++i) {
              const float sc = __builtin_fmaf(-slope[r], fd[tl][i], sv[tl][i]);
              sv[tl][i] = sc;
              mx = fmaxf(mx, sc);
            }
          float sum = ls[r] * __builtin_amdgcn_exp2f(m[r] - mx);
#pragma unroll
          for (int tl = 0; tl < 2; ++tl)
#pragma unroll
            for (int i = 0; i < 4; ++i) sum += __builtin_amdgcn_exp2f(sv[tl][i] - mx);
          ls[r] = sum;
          m[r] = mx;
        }
        if (more) {
#pragma unroll
          for (int tl = 0; tl < 2; ++tl)
#pragma unroll
            for (int ks = 0; ks < 2; ++ks) Kf[tl][ks] = Kn[tl][ks];
        }
      }
    }
#pragma unroll
    for (int r = 0; r < 4; ++r) {
      float mr = fmaxf(m[r], shx(m[r], 16));
      mr = fmaxf(mr, shx(mr, 32));
      float lt = ls[r] * __builtin_amdgcn_exp2f(m[r] - mr);
      lt += shx(lt, 16);
      lt += shx(lt, 32);
      m[r] = mr + __builtin_amdgcn_logf(fmaxf(lt, 1e-30f));
    }
    LAUNDER();
#pragma unroll 1
    for (int i = 0; i < 16; ++i) {
      const u32 j = fq * 64 + i * 4;
      u32x4 kv = {255u - j, 254u - j, 253u - j, 252u - j};
      *reinterpret_cast<u32x4*>(krow + j) = kv;
    }
#pragma unroll
    for (int r = 0; r < 4; ++r)
#pragma unroll
      for (int dt = 0; dt < 4; ++dt) O[r][dt] = f32x4{0.f, 0.f, 0.f, 0.f};
    LAUNDER();
    {
      float carry = 0.f;
      const int krow0 = (fr >> 2) * 8 + (fr & 3);
      bf16x8 Kf[2][2];
      if (nit > 0) ld_kfp(Kc, Kf, krow0, fq);
#pragma unroll 1
      for (int it = 0; it < nit; ++it) {
        bf16x8 Vf[4], Kn[2][2];
        ld_vfp(Vc + (size_t)(it >> 1) * 4096 + (it & 1) * 32, Vf, fr, fq);
        const bool more = (it + 1 < nit);
        if (more) ld_kfp(Kc + (size_t)(it + 1) * 2048, Kn, krow0, fq);
        const int n0 = it * 32 + fq * 8;
        bf16x8 Pb[4];
        f32x4 ps[2] = {f32x4{0.f, 0.f, 0.f, 0.f}, f32x4{0.f, 0.f, 0.f, 0.f}};
        float fd[2][4];
#pragma unroll
        for (int tl = 0; tl < 2; ++tl)
#pragma unroll
          for (int i = 0; i < 4; ++i) {
            const int n = n0 + tl * 4 + i;
            fd[tl][i] = (16 * n + 31 <= t) ? (float)t - (16.f * (float)n + 15.5f) : __builtin_inff();
          }
#pragma unroll
        for (int r = 0; r < 4; ++r) {
          f32x4 sv[2];
          qk_r(Kf, Qf[r], sv[0], sv[1]);
#pragma unroll
          for (int tl = 0; tl < 2; ++tl) {
#pragma unroll
            for (int i = 0; i < 4; ++i)
              sv[tl][i] = __builtin_amdgcn_exp2f(__builtin_fmaf(-slope[r], fd[tl][i], sv[tl][i]) - m[r]);
            ps[tl] += sv[tl];
          }
          Pb[r] = packp(sv[0], sv[1]);
        }
        {
          const float c1 = 0.5f * ps[1][3];
          const float rcv = __shfl(c1, (lane + 48) & 63, 64);
          const float add = fq > 0 ? rcv : carry;
          carry = rcv;
          const float a0 = ps[0][0] + ps[0][1] + ps[0][2] + 0.5f * ps[0][3] + add;
          const float a1 = ps[1][0] + ps[1][1] + ps[1][2] + 0.5f * ps[1][3] + 0.5f * ps[0][3];
          const int j0 = it * 8 + fq * 2;
          u32x2 kk = {(__float_as_uint(a0) & 0xFFFFFF00u) | (u32)(255 - j0), (__float_as_uint(a1) & 0xFFFFFF00u) | (u32)(254 - j0)};
          *reinterpret_cast<u32x2*>(krow + j0) = kk;
        }
        pv_tiles(Vf, Pb, O);
        if (more) {
#pragma unroll
          for (int tl = 0; tl < 2; ++tl)
#pragma unroll
            for (int ks = 0; ks < 2; ++ks) Kf[tl][ks] = Kn[tl][ks];
        }
      }
    }
    LAUNDER();
    {
#pragma unroll
      for (int r = 0; r < 4; ++r) {
        const float gt = gsp[r * 3 + 0];
#pragma unroll
        for (int dt = 0; dt < 4; ++dt) *reinterpret_cast<f32x4*>(onp + r * 64 + dt * 16) = O[r][dt] * gt;
      }
    }
    LAUNDER();
    {
      const u32 F = 0x461C4000u;
      if (fq == 0) krow[0] = F | 255u;
      if (fq == (cur >> 6)) krow[cur] = F | (u32)(255 - cur);
      if (cur >= 1 && fq == ((cur - 1) >> 6)) krow[cur - 1] = F | (u32)(255 - (cur - 1));
    }
    __builtin_amdgcn_wave_barrier();
    u64 mymask = 0ull;
#pragma unroll 1
    for (int rd = 0; rd < 16; ++rd) {
      u32 mx = 0u;
      const u32x4* k4 = reinterpret_cast<const u32x4*>(krow + fq * 64);
#pragma unroll
      for (int i = 0; i < 16; ++i) {
        u32x4 v = k4[i];
        u32 a = v.x > v.y ? v.x : v.y;
        u32 c = v.z > v.w ? v.z : v.w;
        a = a > c ? a : c;
        mx = mx > a ? mx : a;
      }
      u32 o1 = (u32)__shfl_xor((int)mx, 16, 64);
      mx = mx > o1 ? mx : o1;
      u32 o2 = (u32)__shfl_xor((int)mx, 32, 64);
      mx = mx > o2 ? mx : o2;
      const int jw = 255 - (int)(mx & 255u);
      if ((jw >> 6) == fq) {
        krow[jw] = 0u;
        mymask |= 1ull << (jw & 63);
      }
      __builtin_amdgcn_wave_barrier();
    }
    u32 ulo = (u32)mymask, uhi = (u32)(mymask >> 32);
#pragma unroll
    for (int o = 1; o <= 8; o <<= 1) {
      ulo |= (u32)__shfl_xor((int)ulo, o, 64);
      uhi |= (u32)__shfl_xor((int)uhi, o, 64);
    }
    bf16x8* qlds = reinterpret_cast<bf16x8*>(keys);
    u32* list = keys + 2048;
    __builtin_amdgcn_wave_barrier();
#pragma unroll
    for (int r = 0; r < 4; ++r)
#pragma unroll
      for (int ks = 0; ks < 2; ++ks) qlds[(r * 2 + ks) * 64 + lane] = Qf[r][ks];
    int ns = 0;
    const int nhc = ((t0 + 15 - 64 * cur) >> 5) + 1;
#pragma unroll 1
    for (int part = 0; part < 4; ++part) {
      u64 um = ((u64)(u32)__builtin_amdgcn_readlane((int)uhi, part * 16) << 32) |
               (u64)(u32)__builtin_amdgcn_readlane((int)ulo, part * 16);
      while (um) {
        const int bit = __builtin_ctzll(um);
        um &= um - 1;
        const int j = part * 64 + bit;
        if (j > cur) break;
        const int nh = (j == cur) ? nhc : 2;
        if (lane == 0) { list[ns] = (u32)(2 * j); if (nh > 1) list[ns + 1] = (u32)(2 * j + 1); }
        ns += nh;
      }
    }
    __builtin_amdgcn_wave_barrier();
    LAUNDER();
    const u16* KS = (const u16*)(big + B_KS) + (size_t)bg * T * 64;
    const u16* VST = (const u16*)(big + B_VST) + (size_t)bg * 256 * 4096;
#pragma unroll
    for (int r = 0; r < 4; ++r) {
      m[r] = NEG; ls[r] = 0.f;
#pragma unroll
      for (int dt = 0; dt < 4; ++dt) O[r][dt] = f32x4{0.f, 0.f, 0.f, 0.f};
    }
    att_loop<1>(ns, list, KS, VST, t, t0, mymask, qlds, lane, fr, fq, slope, m, ls, O);
    LAUNDER();
#pragma unroll
    for (int r = 0; r < 4; ++r) {
      float lt = ls[r] + shx(ls[r], 16);
      lt += shx(lt, 32);
      const float sc = gsp[r * 3 + 1] / fmaxf(lt, 1e-30f);
#pragma unroll
      for (int dt = 0; dt < 4; ++dt) {
        f32x4* ptr = reinterpret_cast<f32x4*>(onp + r * 64 + dt * 16);
        *ptr = *ptr + O[r][dt] * sc;
      }
    }
    LAUNDER();
    const u16* KW = (const u16*)(big + B_KW) + (size_t)bg * T * 64;
    const u16* VWT = (const u16*)(big + B_VWT) + (size_t)bg * 256 * 4096;
#pragma unroll
    for (int r = 0; r < 4; ++r) {
      m[r] = NEG; ls[r] = 0.f;
#pragma unroll
      for (int dt = 0; dt < 4; ++dt) O[r][dt] = f32x4{0.f, 0.f, 0.f, 0.f};
    }
    {
      const int lo = t0 - 511 > 0 ? t0 - 511 : 0;
      const int e0 = (lo >> 6) * 2;
      const int nsw = cur * 2 + nhc - e0;
      __builtin_amdgcn_wave_barrier();
#pragma unroll 1
      for (int i = lane; i < nsw; i += 64) list[i] = (u32)(e0 + i);
      __builtin_amdgcn_wave_barrier();
      att_loop<2>(nsw, list, KW, VWT, t, t0, 0ull, qlds, lane, fr, fq, slope, m, ls, O);
    }
    LAUNDER();
#pragma unroll
    for (int r = 0; r < 4; ++r) {
      float lt = ls[r] + shx(ls[r], 16);
      lt += shx(lt, 32);
      const float sc = gsp[r * 3 + 2] / fmaxf(lt, 1e-30f);
#pragma unroll
      for (int dt = 0; dt < 4; ++dt) {
        f32x4* ptr = reinterpret_cast<f32x4*>(onp + r * 64 + dt * 16);
        f32x4 v = *ptr + O[r][dt] * sc;
        ssq += v[0] * v[0] + v[1] * v[1] + v[2] * v[2] + v[3] * v[3];
        O[r][dt] = v;
      }
    }
  }
  LAUNDER();
  ssq += shx(ssq, 16);
  ssq += shx(ssq, 32);
  if (fq == 0) xch[wid * 16 + fr] = ssq;
  __syncthreads();
  const float tot = ssq + xch[(wid ^ 1) * 16 + fr];
  const float rinv = rsqrtf(tot * (1.f / 512.f) + EPS);
  const float* gn = p.nsa_out_g + (size_t)l * 512 + g * 256 + fq * 8;
  u16* cp = CAT + tok * 1024 + g * 256 + fq * 8;
#pragma unroll
  for (int r = 0; r < 4; ++r)
#pragma unroll
    for (int pp = 0; pp < 2; ++pp) {
      f32x4 g0 = *reinterpret_cast<const f32x4*>(gn + r * 64 + pp * 32), g1 = *reinterpret_cast<const f32x4*>(gn + r * 64 + pp * 32 + 4);
      st8bf_n(cp + r * 64 + pp * 32, O[r][2 * pp] * g0 * rinv, O[r][2 * pp + 1] * g1 * rinv);
    }
}
#undef LAUNDER
__device__ __forceinline__ void ret_kv_block(const P& p, int first, int step, unsigned char* smem) {
  const int tid = tidx(), lane = tid & 63, wid = __builtin_amdgcn_readfirstlane(tid >> 6), fr = lane & 15, fq = lane >> 4;
  u32x4 rg[8];
  auto gload = [&](int ch) {
    const u16* Kt = (const u16*)(p.ws + O_BIG + B_KRT) + (size_t)ch * 16384;
    const u16* Vt = (const u16*)(p.ws + O_BIG + B_VRT) + (size_t)ch * 16384;
#pragma unroll
    for (int i = 0; i < 8; ++i) {
      const int slot = wid * 8 + i;
      const u16* src = (slot < 32 ? Kt : Vt) + (((slot & 31) >> 2) * 16 + fr) * 128 + (slot & 3) * 32 + fq * 8;
      rg[i] = *reinterpret_cast<const u32x4*>(src);
    }
  };
  if (first < 1024) gload(first);
  for (int ch = first; ch < 1024; ch += step) {
    __syncthreads();
#pragma unroll
    for (int i = 0; i < 8; ++i) *reinterpret_cast<u32x4*>(smem + (wid * 8 + i) * 1024 + lane * 16) = rg[i];
    __syncthreads();
    if (ch + step < 1024) gload(ch + step);
    float* KVF = (float*)(p.ws + O_Y) + (size_t)ch * 16384;
    const unsigned char* lb = smem + lane * 16;
    bf16x8 Af[4];
#pragma unroll
    for (int ks = 0; ks < 4; ++ks) Af[ks] = *reinterpret_cast<const bf16x8*>(lb + (wid * 4 + ks) * 1024);
#pragma unroll
    for (int et = 0; et < 8; ++et) {
      f32x4 acc = {0.f, 0.f, 0.f, 0.f};
#pragma unroll
      for (int ks = 0; ks < 4; ++ks) acc = mfma16(Af[ks], *reinterpret_cast<const bf16x8*>(lb + (32 + et * 4 + ks) * 1024), acc);
      *reinterpret_cast<f32x4*>(KVF + (et * 16 + fr) * 128 + wid * 16 + fq * 4) = acc;
    }
  }
}
__device__ __forceinline__ void ret_scan(const P& p) {
  const float* KVF = (const float*)(p.ws + O_Y);
  u16* ST = (u16*)(p.ws + O_Y + 64 * MiB);
  const int gt = bidx() * 512 + tidx(), nt = gdim() * 512;
  for (int idx = gt; idx < 8 * 4096; idx += nt) {
    const int bh = idx >> 12, ed = (idx & 4095) * 4, h = bh & 3;
    const float cd = exp2f(128.f * ret_lg(h));
    f32x4 st = {0.f, 0.f, 0.f, 0.f};
    const size_t base = (size_t)bh * 128 * 16384 + ed;
#pragma unroll 4
    for (int c = 0; c < 128; ++c) {
      st4bf(ST + base + (size_t)c * 16384, st);
      st = st * cd + *reinterpret_cast<const f32x4*>(KVF + base + (size_t)c * 16384);
    }
  }
}
__device__ __forceinline__ void ret_out_block(const P& p, int l, int first, int step, unsigned char* smem) {
  const int tid = tidx(), lane = tid & 63, wid = __builtin_amdgcn_readfirstlane(tid >> 6), fr = lane & 15, fq = lane >> 4;
  unsigned char* big = p.ws + O_BIG;
  const u16* QR = (const u16*)(big + B_QR);
  const u16* KR = (const u16*)(big + B_KR);
  const u16* GR = (const u16*)(big + B_GR);
  u16* CAT = (u16*)(p.ws + O_HB);
  const int krow0 = (fr >> 2) * 8 + (fr & 3);
  u32x4 rg[12];
  auto gload = [&](int ch) {
    const int c = ch & 127, bh = ch >> 7, h = bh & 3, b = bh >> 2;
    const size_t tokc = (size_t)b * T + (size_t)c * 128;
    const u16* Vt = (const u16*)(big + B_VRT) + (size_t)ch * 16384;
    const u16* ST = (const u16*)(p.ws + O_Y + 64 * MiB) + (size_t)ch * 16384;
#pragma unroll
    for (int i = 0; i < 12; ++i) {
      const int slot = wid * 12 + i;
      const u16* src;
      if (slot < 32) {
        const int u = slot >> 3, tl = (slot >> 2) & 1, ks = slot & 3;
        src = KR + (tokc + u * 32 + krow0 + tl * 4) * 512 + h * 128 + ks * 32 + fq * 8;
      } else if (slot < 64) {
        const int et = (slot - 32) >> 2, u = slot & 3;
        src = Vt + ((et >> 1) * 32 + (fr >> 2) * 8 + (et & 1) * 4 + (fr & 3)) * 128 + u * 32 + fq * 8;
      } else {
        const int et = (slot - 64) >> 2, ks = slot & 3;
        src = ST + ((et >> 1) * 32 + (fr >> 2) * 8 + (et & 1) * 4 + (fr & 3)) * 128 + ks * 32 + fq * 8;
      }
      rg[i] = *reinterpret_cast<const u32x4*>(src);
    }
  };
  if (first < 1024) gload(first);
  for (int ch = first; ch < 1024; ch += step) {
    const int c = ch & 127, bh = ch >> 7, h = bh & 3, b = bh >> 2;
    __syncthreads();
#pragma unroll
    for (int i = 0; i < 12; ++i) *reinterpret_cast<u32x4*>(smem + (wid * 12 + i) * 1024 + lane * 16) = rg[i];
    __syncthreads();
    if (ch + step < 1024) gload(ch + step);
    const size_t tokc = (size_t)b * T + (size_t)c * 128;
    const int n = wid * 16 + fr;
    const size_t tok = tokc + n;
    const float lg = ret_lg(h);
    bf16x8 Qf[4];
#pragma unroll
    for (int ks = 0; ks < 4; ++ks) Qf[ks] = ld8(QR + tok * 512 + h * 128 + ks * 32 + fq * 8);
    f32x4 O[8];
#pragma unroll
    for (int et = 0; et < 8; ++et) O[et] = f32x4{0.f, 0.f, 0.f, 0.f};
    const unsigned char* lb = smem + lane * 16;
    const int nu = (wid >> 1) + 1;
#pragma unroll 1
    for (int u = 0; u < nu; ++u) {
      f32x4 S[2];
#pragma unroll
      for (int tl = 0; tl < 2; ++tl) {
        f32x4 z = {0.f, 0.f, 0.f, 0.f};
#pragma unroll
        for (int ks = 0; ks < 4; ++ks) z = mfma16(*reinterpret_cast<const bf16x8*>(lb + (u * 8 + tl * 4 + ks) * 1024), Qf[ks], z);
#pragma unroll
        for (int i = 0; i < 4; ++i) {
          const int diff = n - (u * 32 + fq * 8 + tl * 4 + i);
          z[i] = diff >= 0 ? z[i] * __builtin_amdgcn_exp2f((float)diff * lg) : 0.f;
        }
        S[tl] = z;
      }
      bf16x8 Pb = packp(S[0], S[1]);
#pragma unroll
      for (int et = 0; et < 8; ++et) O[et] = mfma16(*reinterpret_cast<const bf16x8*>(lb + (32 + et * 4 + u) * 1024), Pb, O[et]);
    }
    const float qd = __builtin_amdgcn_exp2f((float)(n + 1) * lg);
    float s1 = 0.f;
#pragma unroll
    for (int et = 0; et < 8; ++et) {
      f32x4 x = {0.f, 0.f, 0.f, 0.f};
#pragma unroll
      for (int ks = 0; ks < 4; ++ks) x = mfma16(*reinterpret_cast<const bf16x8*>(lb + (64 + et * 4 + ks) * 1024), Qf[ks], x);
      O[et] += x * qd;
      s1 += O[et][0] + O[et][1] + O[et][2] + O[et][3];
    }
    s1 += shx(s1, 16);
    s1 += shx(s1, 32);
    const float mu = s1 * (1.f / 128.f);
    float s2 = 0.f;
#pragma unroll
    for (int et = 0; et < 8; ++et) {
      O[et] -= mu;
      s2 += O[et][0] * O[et][0] + O[et][1] * O[et][1] + O[et][2] * O[et][2] + O[et][3] * O[et][3];
    }
    s2 += shx(s2, 16);
    s2 += shx(s2, 32);
    const float rinv = rsqrtf(s2 * (1.f / 128.f) + EPS);
    const float* gn = p.ret_gn_g + (size_t)l * 512 + h * 128;
#pragma unroll
    for (int pp = 0; pp < 4; ++pp) {
      const int e = pp * 32 + fq * 8;
      f32x4 g0 = *reinterpret_cast<const f32x4*>(gn + e), g1 = *reinterpret_cast<const f32x4*>(gn + e + 4);
      u32x4 gr = *reinterpret_cast<const u32x4*>(GR + tok * 512 + h * 128 + e);
      f32x4 sg0, sg1;
      bf8_to_f32(gr, sg0, sg1);
      st8bf_n(CAT + tok * 1024 + 512 + h * 128 + e, O[2 * pp] * rinv * g0 * sg0, O[2 * pp + 1] * rinv * g1 * sg1);
    }
  }
}

__device__ __forceinline__ void xattn_block(const P& p, int id, unsigned char* smem) {
  const int tid = tidx(), lane = tid & 63, wid = __builtin_amdgcn_readfirstlane(tid >> 6), fr = lane & 15, fq = lane >> 4;
  const int qb = id & 127, hd = (id >> 7) & 3, b = id >> 9;
  const u16* QX = (const u16*)(p.ws + O_BIG);
  u16* OX = (u16*)(p.ws + O_BIG + 64 * MiB);
  const u16* KM = (const u16*)(p.ws + O_SMALL + S_KMEM) + (size_t)b * 256 * 1024 + hd * 256;
  const u16* VM = (const u16*)(p.ws + O_SMALL + S_VMEMT) + ((size_t)b * 1024 + hd * 256) * 256;
  const size_t tok = (size_t)b * T + qb * 128 + wid * 16 + fr;
  bf16x8 Qf[8];
#pragma unroll
  for (int ks = 0; ks < 8; ++ks) Qf[ks] = ld8(QX + tok * 1024 + hd * 256 + ks * 32 + fq * 8);
  f32x4 O[16];
#pragma unroll
  for (int et = 0; et < 16; ++et) O[et] = f32x4{0.f, 0.f, 0.f, 0.f};
  float m = NEG, ls = 0.f;
  const int krow0 = (fr >> 2) * 8 + (fr & 3);
  u32x4 rk[2], rv[2];
  auto gload = [&](int c) {
#pragma unroll
    for (int i = 0; i < 2; ++i) {
      const int slot = wid * 2 + i, tl = slot >> 3, ks = slot & 7;
      rk[i] = *reinterpret_cast<const u32x4*>(KM + (size_t)(c * 32 + krow0 + tl * 4) * 1024 + ks * 32 + fq * 8);
      rv[i] = *reinterpret_cast<const u32x4*>(VM + (size_t)((slot >> 1) * 32 + (fr >> 2) * 8 + (slot & 1) * 4 + (fr & 3)) * 256 + c * 32 + fq * 8);
    }
  };
  auto swrite = [&](int buf) {
#pragma unroll
    for (int i = 0; i < 2; ++i) {
      const int slot = wid * 2 + i;
      *reinterpret_cast<u32x4*>(smem + buf * 32768 + slot * 1024 + lane * 16) = rk[i];
      *reinterpret_cast<u32x4*>(smem + buf * 32768 + 16384 + slot * 1024 + lane * 16) = rv[i];
    }
  };
  __syncthreads();
  gload(0);
  swrite(0);
  __syncthreads();
#pragma unroll 1
  for (int c = 0; c < 8; ++c) {
    const int buf = c & 1;
    if (c + 1 < 8) gload(c + 1);
    const unsigned char* kb = smem + buf * 32768 + lane * 16;
    const unsigned char* vb = kb + 16384;
    f32x4 S[2];
#pragma unroll
    for (int tl = 0; tl < 2; ++tl) {
      f32x4 z = {0.f, 0.f, 0.f, 0.f};
#pragma unroll
      for (int ks = 0; ks < 8; ++ks) z = mfma16(*reinterpret_cast<const bf16x8*>(kb + (tl * 8 + ks) * 1024), Qf[ks], z);
      S[tl] = z;
    }
    float mx = fmaxf(fmaxf(fmaxf(S[0][0], S[0][1]), fmaxf(S[0][2], S[0][3])), fmaxf(fmaxf(S[1][0], S[1][1]), fmaxf(S[1][2], S[1][3])));
    mx = fmaxf(mx, shx(mx, 16));
    mx = fmaxf(mx, shx(mx, 32));
    const float mn = fmaxf(m, mx);
    const float alpha = __expf(m - mn);
    float sum = 0.f;
#pragma unroll
    for (int tl = 0; tl < 2; ++tl)
#pragma unroll
      for (int i = 0; i < 4; ++i) {
        float e = __expf(S[tl][i] - mn);
        S[tl][i] = e;
        sum += e;
      }
    ls = ls * alpha + sum;
    m = mn;
    bf16x8 Pb = packp(S[0], S[1]);
#pragma unroll
    for (int et = 0; et < 16; ++et) {
      O[et] *= alpha;
      O[et] = mfma16(*reinterpret_cast<const bf16x8*>(vb + et * 1024), Pb, O[et]);
    }
    if (c + 1 < 8) swrite(buf ^ 1);
    __syncthreads();
  }
  ls += shx(ls, 16);
  ls += shx(ls, 32);
  const float inv = 1.f / ls;
#pragma unroll
  for (int pp = 0; pp < 8; ++pp) st8bf_n(OX + tok * 1024 + hd * 256 + pp * 32 + fq * 8, O[2 * pp] * inv, O[2 * pp + 1] * inv);
}

#define XB_TMO      128
#define XB_XCNT(j)  (256  + 64 * (j))
#define XB_XSUB(j)  (1280 + 64 * (j))
#define XB_XGEN(j)  (2304 + 64 * (j))
#define XB_TOP      3328
#define XB_TOPGEN   3392
#define XCD_BAR_WORDS 3456
#define XB_SPIN_CAP (1u << 18)
#define LAS __attribute__((address_space(3)))

__device__ __forceinline__ unsigned xb_ld(unsigned* p)              { return __hip_atomic_load(p, __ATOMIC_RELAXED, __HIP_MEMORY_SCOPE_AGENT); }
__device__ __forceinline__ unsigned xb_add(unsigned* p, unsigned v) { return __hip_atomic_fetch_add(p, v, __ATOMIC_RELAXED, __HIP_MEMORY_SCOPE_AGENT); }
__device__ __forceinline__ unsigned xb_xcc_id() { return (unsigned)__builtin_amdgcn_s_getreg((3 << 11) | 20) & 0xFu; }
#define XB_SPIN(cond, bar) do { unsigned _sp = 0; while (cond) { __builtin_amdgcn_s_sleep(1); \
    if ((++_sp & 255u) == 0u) { if (xb_ld(&(bar)[XB_TMO])) break; if (_sp > XB_SPIN_CAP) { atomicAdd(&(bar)[XB_TMO], 1u); break; } } } } while (0)

struct XcdBarrier {
    unsigned* bar; unsigned x;
    volatile LAS unsigned* st;
};

__device__ __forceinline__ XcdBarrier xcd_barrier_post(unsigned* bar, volatile LAS unsigned* st) {
    XcdBarrier b; b.bar = bar; b.x = xb_xcc_id(); b.st = st;
    if (threadIdx.x == 0) (void)xb_add(&bar[XB_XCNT(b.x)], 1u);
    return b;
}
__device__ __forceinline__ void xcd_barrier_complete(unsigned* bar, unsigned x, unsigned& nloc, unsigned& nx) {
    const unsigned G = gridDim.x * gridDim.y * gridDim.z;
    unsigned sum, cnt, mine, sp = 0u;
    for (;;) {
        sum = 0u; cnt = 0u; mine = 0u;
#pragma unroll
        for (unsigned j = 0; j < 16; ++j) { const unsigned c = xb_ld(&bar[XB_XCNT(j)]); sum += c; cnt += (c > 0u) ? 1u : 0u; mine = (j == x) ? c : mine; }
        if (sum == G) break;
        __builtin_amdgcn_s_sleep(1);
        if ((++sp & 255u) == 0u) { if (xb_ld(&bar[XB_TMO])) break; if (sp > XB_SPIN_CAP) { atomicAdd(&bar[XB_TMO], 1u); break; } }
    }
    nloc = mine > 0u ? mine : 1u; nx = cnt > 0u ? cnt : 1u;
}

__device__ __forceinline__ void xcd_barrier(const XcdBarrier& b) {
    asm volatile("s_waitcnt vmcnt(0)" ::: "memory");
    __syncthreads();
    if (threadIdx.x == 0) {
        unsigned* bar = b.bar;
        __builtin_amdgcn_s_waitcnt(0);
        unsigned nloc = b.st[0], nx = b.st[1];
        if (nloc == 0u) { xcd_barrier_complete(bar, b.x, nloc, nx); b.st[0] = nloc; b.st[1] = nx; }
        const unsigned old = xb_add(&bar[XB_XSUB(b.x)], 1u);
        const unsigned gen = old / nloc;
        if (old + 1u == (gen + 1u) * nloc) {
            __builtin_amdgcn_fence(__ATOMIC_RELEASE, "agent");
            asm volatile("s_waitcnt vmcnt(0)" ::: "memory");
            const unsigned og = xb_add(&bar[XB_TOP], 1u);
            const unsigned tg = og / nx;
            if (og + 1u == (tg + 1u) * nx) xb_add(&bar[XB_TOPGEN], 1u);
            else XB_SPIN(xb_ld(&bar[XB_TOPGEN]) == tg, bar);
            __builtin_amdgcn_fence(__ATOMIC_ACQUIRE, "agent");
            xb_add(&bar[XB_XGEN(b.x)], 1u);
            asm volatile("s_waitcnt vmcnt(0)" ::: "memory");
        } else {
            XB_SPIN(xb_ld(&bar[XB_XGEN(b.x)]) == gen, bar);
            __builtin_amdgcn_fence(__ATOMIC_ACQUIRE, "agent");
            asm volatile("s_waitcnt vmcnt(0)" ::: "memory");
        }
    }
    __syncthreads();
}

__device__ __forceinline__ void run_phase(const P& p, int ph, unsigned char* smem) {
  unsigned char* ws = p.ws;
  u16* sm = reinterpret_cast<u16*>(smem);
  u16* HB = (u16*)(ws + O_HB);
  float* Y = (float*)(ws + O_Y);
  unsigned char* big = ws + O_BIG;
  u16* ACT = (u16*)big;
  const int wid = __builtin_amdgcn_readfirstlane(tidx() >> 6);
  const int gw = bidx() * 8 + wid, nw = gdim() * 8;
  const int l = ph == 0 ? 0 : (ph - 1) >> 4;
  const int sub = ph == 0 ? -1 : (ph - 1) & 15;
  const u16* memn = (const u16*)(ws + O_SMALL + S_MEMN) + (size_t)l * 512 * 1024;

  {
    u16* XB = (u16*)((unsigned char*)p.out + 64 * MiB);
    int njobs = 0;
    if (ph == 0) njobs = 3;
    else if (sub == 2 || sub == 8 || sub == 12 || sub == 15) njobs = 1;
    for (int jb = 0; jb < njobs; ++jb) {
      const float *xin_f = nullptr, *gpost = nullptr, *gpre = nullptr;
      const u16 *xin_b = XB, *y = (const u16*)Y;
      u16 *xout_b = XB, *hb = HB;
      float *xout_f = nullptr, *xout_f2 = nullptr;
      float w = 1.f;
      int ntok = NTOK;
      if (ph == 0) {
        if (jb == 0) { xin_f = p.x; xin_b = nullptr; y = nullptr; gpre = p.ffn1_pre_g; }
        else {
          xin_f = p.mem; xin_b = nullptr; y = nullptr; xout_b = nullptr; gpre = p.xa_mem_g + (jb - 1) * 1024;
          hb = (u16*)(ws + O_SMALL + S_MEMN) + (size_t)(jb - 1) * 512 * 1024; ntok = 512;
        }
      } else if (sub == 2) { gpost = p.ffn1_post_g + l * 1024; w = 0.5f; gpre = p.mix_pre_g + l * 1024; }
      else if (sub == 8) { gpost = p.mix_post_g + l * 1024; gpre = p.xa_pre_g + l * 1024; }
      else if (sub == 12) { gpost = p.xa_post_g + l * 1024; gpre = p.ffn2_pre_g + l * 1024; if (l == 1) xout_b = (u16*)(big + 176 * MiB); }
      else {
        gpost = p.ffn2_post_g + l * 1024; w = 0.5f;
        if (l == 0) gpre = p.ffn1_pre_g + 1024;
        else {
          gpre = nullptr; hb = nullptr; xout_b = nullptr; xin_b = (const u16*)(big + 176 * MiB); xout_f = p.out; xout_f2 = p.out;
        }
      }
      norm_phase(xin_f, xin_b, y, gpost, w, xout_b, xout_f, xout_f2, gpre, hb, ntok);
    }
  }
  if (ph == 0 || (sub == 15 && l == 0)) convert_layer(p, ph == 0 ? 0 : 1, smem);
  if (sub == 0 || sub == 13) {
    EpiSwiglu E{ACT};
    big_gemm(smem, HB, (const u16*)(ws + (sub == 0 ? W_GU1 : W_GU2)), NTOK, 5632, 1024, E);
  }
  if (sub == 1 || sub == 7 || sub == 11 || sub == 14) {
    const u16* A = ACT; const u16* Bt = (u16*)(ws + W_D1); int K = DFF;
    if (sub == 7) { A = HB; Bt = (u16*)(ws + W_OUT); K = 1024; }
    else if (sub == 11) { A = (const u16*)(big + 64 * MiB); Bt = (u16*)(ws + W_O); K = 1024; }
    else if (sub == 14) { Bt = (u16*)(ws + W_D2); }
    EpiY E{(u16*)Y, 1024};
    big_gemm(smem, A, Bt, NTOK, 1024, K, E);
  }
  if (sub == 9) {
    EpiQ E{(u16*)big, 0.0625f};
    big_gemm(smem, HB, (const u16*)(ws + W_Q), NTOK, 1024, 1024, E);
  }
  if (sub == 3) {
    EpiWin E{big};
    big_gemm(smem, HB, (const u16*)(ws + W_IN), NTOK, 3584, 1024, E);
  }
  if (sub == 4) {
#pragma unroll 1
    for (int kv = 0; kv < 2; ++kv) {
      EpiC1 E{(u16*)(ws + O_SMALL + S_HC) + (size_t)kv * 4096 * 256, reinterpret_cast<const float*>(ws + W_BIAS) + kv * 8 * 256};
      big_gemm(smem, (const u16*)(big + (kv == 0 ? B_KCR : B_VCR)), (const u16*)(ws + W_C1) + (size_t)kv * 256 * 2048, 4096, 256, 2048,
               E, 1024, kv * 16);
    }
    gemm_phase<EP_BF16>(p, 0, 1.f, ws + O_SMALL + S_KMEM, 1024, memn, 1024, (u16*)(ws + W_K), 1024, 512, 1024, 1024, sm, 64);
    gemm_phase<EP_VMEMT>(p, 0, 1.f, ws + O_SMALL + S_VMEMT, 0, memn, 1024, (u16*)(ws + W_V), 1024, 512, 1024, 1024, sm, 96);
    ret_kv_block(p, bidx(), gdim(), smem);
  }
  if (sub == 5) {
    gemm_phase<EP_C2K>(p, 0, 1.f, ws + O_SMALL + S_KCC, 64, (const u16*)(ws + O_SMALL + S_HC), 256, (u16*)(ws + W_C2), 256,
                       4096, 128, 256, sm, 0);
    gemm_phase<EP_C2V>(p, 0, 1.f, ws + O_SMALL + S_VCT, 64, (const u16*)(ws + O_SMALL + S_HC) + (size_t)4096 * 256, 256,
                       (u16*)(ws + W_C2) + 128 * 256, 256, 4096, 128, 256, sm, 128);
    ret_scan(p);
  }
  if (sub == 6) {
    u32* keys = reinterpret_cast<u32*>(smem) + wid * 16 * KEYSTR;
    const int slots = gdim() * 4;
    for (int i = 0; i * slots < 2048; ++i) {
      const int Gs = gdim(), bs = (Gs & 7) == 0 ? (bidx() & 7) * (Gs >> 3) + (bidx() >> 3) : bidx();
      const int u = i * slots + bs * 4 + (wid >> 1);
      float* xch = reinterpret_cast<float*>(smem + SMEM_BYTES + 64) + (i & 1) * 128;
      if (u < 2048) {
        const int v = u & 1023, bq = (v >> 2) & 1, ti = ((v >> 3) << 2) + (v & 3);
        const int qt = u < 1024 ? 1023 - ti : ti;
        nsa_task(p, l, bq, qt, (wid & 1) ^ (i & 1), keys, xch, wid);
      } else {
        __syncthreads();
      }
    }
    ret_out_block(p, l, bidx(), gdim(), smem);
  }
  if (sub == 10)
    for (int id = bidx(); id < 1024; id += gdim()) xattn_block(p, id, smem);
}

__global__ void __launch_bounds__(512) hymba_mega(P p, int ph0, int ph1) {
  extern __shared__ __attribute__((aligned(16))) unsigned char smem[];
  cg::grid_group grid = cg::this_grid();
  volatile LAS unsigned* st = (volatile LAS unsigned*)(smem + SMEM_BYTES);
  if (threadIdx.x < 4) st[threadIdx.x] = 0u;
  __syncthreads();
  XcdBarrier xb = xcd_barrier_post((unsigned*)(p.ws + O_SMALL + S_BAR), st);
  for (int ph = ph0; ph < ph1; ++ph) {
#if defined(__HIP_DEVICE_COMPILE__)
    const __attribute__((address_space(4))) P* pp =
        (const __attribute__((address_space(4))) P*)__builtin_amdgcn_kernarg_segment_ptr();
    asm volatile("" : "+s"(pp));
    P q = *pp;
    run_phase(q, ph, smem);
#endif
    if (ph + 1 < ph1) {
      if (ph1 < 0) grid.sync();
      xcd_barrier(xb);
    }
  }
}

extern "C" void kernel_launch(void* const* d_in, const int* in_sizes, int n_in, void* d_out, int out_size, void* d_ws,
                              size_t ws_size, hipStream_t stream) {
  P p{};
  const float** pp = reinterpret_cast<const float**>(&p);
  for (int i = 0; i < 28; ++i) pp[i] = (const float*)d_in[i];
  p.out = (float*)d_out;
  p.ws = (unsigned char*)d_ws;
  if (ws_size < WS_NEED) {
    fprintf(stderr, "workspace too small: %zu < %zu\n", ws_size, (size_t)WS_NEED);
    return;
  }
  static int grid_blocks = 0;
  if (!grid_blocks) {
    hipFuncSetAttribute((const void*)hymba_mega, hipFuncAttributeMaxDynamicSharedMemorySize, SMEM_BYTES + 64 + 1024);
    int dev = 0, cus = 0, per = 0;
    hipGetDevice(&dev);
    hipDeviceGetAttribute(&cus, hipDeviceAttributeMultiprocessorCount, dev);
    hipOccupancyMaxActiveBlocksPerMultiprocessor(&per, hymba_mega, 512, SMEM_BYTES + 64 + 1024);
    if (per < 1) per = 1;
    grid_blocks = cus * per;
  }
  hipMemsetAsync((unsigned char*)d_ws + O_SMALL + S_BAR, 0, 16384, stream);
  int ph0 = 0, ph1 = NPH;
  void* args[] = {&p, &ph0, &ph1};
  hipError_t e = hipLaunchCooperativeKernel((void*)hymba_mega, dim3(grid_blocks), dim3(512), args, SMEM_BYTES + 64 + 1024, stream);
  if (e != hipSuccess) fprintf(stderr, "cooperative launch failed: %s (grid %d)\n", hipGetErrorString(e), grid_blocks);
}
```
